# Optimizing an MI355X kernel written in HIP

```python
import jax, jax.numpy as jnp
from jax import lax
import numpy as np

D_MODEL = 1024
BATCH = 4
SEQ = 8192
DEPTH = 1

HEAD_DIM = 64
ATTN_PATTERNS = ((128, 1), (512, 4), (2048, 16))
N_PATTERNS = 3
HEADS_PER_PATTERN = 4
N_ATTN_HEADS = N_PATTERNS * HEADS_PER_PATTERN
ATTN_WIDTH = N_ATTN_HEADS * HEAD_DIM
ATTN_OUT_WIDTH = HEADS_PER_PATTERN * HEAD_DIM
N_KEYS = ATTN_PATTERNS[0][0] // ATTN_PATTERNS[0][1] + 1
Q_BLOCK = 128
REL_BUCKETS = 32
REL_MAX_DIST = 2048
SSM_GROUP = 16
SSM_STATE = 64
SSM_WIDTH = 512
SSM_GROUPS = SSM_WIDTH // SSM_GROUP
DT_MIN = 1e-3
DT_MAX = 1e-1
MEM_LEN = 256
XATTN_HEADS = 4
XATTN_HEAD_DIM = 128
XATTN_WIDTH = XATTN_HEADS * XATTN_HEAD_DIM
N_BRANCHES = 3
IN_WIDTH = SSM_WIDTH + 3 * ATTN_WIDTH + XATTN_WIDTH + N_BRANCHES * D_MODEL
D_FF = 2816
EPS = 1e-6

kernel_name = "hybrid_s5_dilated_attn_gated_block"


def rmsnorm(x, g):
    xf = x.astype(jnp.float32)
    y = xf * lax.rsqrt(jnp.mean(xf * xf, axis=-1, keepdims=True) + EPS)
    return (y * g.astype(jnp.float32)).astype(x.dtype)


def swiglu_ffn(x, w_in, w_down):
    a, b = jnp.split(x @ w_in, 2, axis=-1)
    return (jax.nn.silu(a) * b) @ w_down


def t5_causal_buckets(dist):
    dist = np.asarray(dist, np.int32)
    max_exact = REL_BUCKETS // 2
    safe = np.maximum(dist, 1).astype(np.float32)
    large = max_exact + (np.log(safe / max_exact) / np.log(REL_MAX_DIST / max_exact)
                         * (REL_BUCKETS - max_exact)).astype(np.int32)
    large = np.minimum(large, REL_BUCKETS - 1)
    return np.where(dist < max_exact, dist, large).astype(np.int32)


def pattern_offsets():
    return np.stack([np.arange(N_KEYS, dtype=np.int32) * d for (_, d) in ATTN_PATTERNS])


def s5_scan(u, a_re, a_im, log_dt, b_re, b_im, c_re, c_im, d_skip):
    bsz, seqlen, _ = u.shape
    f32 = jnp.float32
    uf = u.astype(f32).reshape(bsz, seqlen, SSM_GROUPS, SSM_GROUP)
    a_re = a_re.astype(f32); a_im = a_im.astype(f32)
    dt = jnp.exp(log_dt.astype(f32))[:, None]
    mag = jnp.exp(a_re * dt)
    ang = a_im * dt
    abar_re = mag * jnp.cos(ang)
    abar_im = mag * jnp.sin(ang)
    nr = abar_re - 1.0
    ni = abar_im
    den = a_re * a_re + a_im * a_im
    coef_re = (nr * a_re + ni * a_im) / den
    coef_im = (ni * a_re - nr * a_im) / den
    b_re = b_re.astype(f32); b_im = b_im.astype(f32)
    bbar_re = coef_re[..., None] * b_re - coef_im[..., None] * b_im
    bbar_im = coef_re[..., None] * b_im + coef_im[..., None] * b_re
    bu_re = jnp.einsum('blgh,gph->blgp', uf, bbar_re)
    bu_im = jnp.einsum('blgh,gph->blgp', uf, bbar_im)
    a_seq_re = jnp.broadcast_to(abar_re[None, None], (1, seqlen, SSM_GROUPS, SSM_STATE))
    a_seq_im = jnp.broadcast_to(abar_im[None, None], (1, seqlen, SSM_GROUPS, SSM_STATE))

    def combine(e1, e2):
        a1r, a1i, b1r, b1i = e1
        a2r, a2i, b2r, b2i = e2
        return (a2r * a1r - a2i * a1i,
                a2r * a1i + a2i * a1r,
                a2r * b1r - a2i * b1i + b2r,
                a2r * b1i + a2i * b1r + b2i)

    _, _, x_re, x_im = lax.associative_scan(combine, (a_seq_re, a_seq_im, bu_re, bu_im), axis=1)
    y = (jnp.einsum('blgp,ghp->blgh', x_re, c_re.astype(f32))
         - jnp.einsum('blgp,ghp->blgh', x_im, c_im.astype(f32))
         + uf * d_skip.astype(f32))
    return y.reshape(bsz, seqlen, SSM_WIDTH).astype(u.dtype)


def dilated_mixture_attention(q, k, v, rel_table):
    bsz, seqlen = q.shape[0], q.shape[1]
    f32 = jnp.float32
    offsets = pattern_offsets()
    buckets = t5_causal_buckets(offsets)
    table = rel_table.astype(f32).reshape(REL_BUCKETS, N_PATTERNS, HEADS_PER_PATTERN)
    grp = np.arange(N_PATTERNS)[:, None]
    bias = jnp.transpose(table[buckets, grp], (0, 2, 1))
    grp3 = np.arange(N_PATTERNS)[:, None, None]
    scale = HEAD_DIM ** -0.5

    def block(start):
        qb = lax.dynamic_slice_in_dim(q, start, Q_BLOCK, axis=1).astype(f32)
        pos = start + jnp.arange(Q_BLOCK, dtype=jnp.int32)
        idx = pos[None, :, None] - offsets[:, None, :]
        valid = idx >= 0
        idx = jnp.maximum(idx, 0)
        kb = k[:, idx, grp3].astype(f32)
        vb = v[:, idx, grp3].astype(f32)
        logits = jnp.einsum('bqghd,bgqkhd->bghqk', qb, kb) * scale + bias[None, :, :, None, :]
        logits = jnp.where(valid[None, :, None], logits, -jnp.inf)
        lse = jax.nn.logsumexp(logits, axis=-1)
        probs = jnp.exp(logits - lse[..., None])
        out = jnp.einsum('bghqk,bgqkhd->bqghd', probs, vb)
        mix = jax.nn.softmax(lse, axis=1)
        return jnp.einsum('bghq,bqghd->bqhd', mix, out).astype(q.dtype)

    starts = jnp.arange(seqlen // Q_BLOCK, dtype=jnp.int32) * Q_BLOCK
    out = lax.map(block, starts)
    return out.transpose(1, 0, 2, 3, 4).reshape(bsz, seqlen, ATTN_OUT_WIDTH)


def memory_cross_attention(xq, mem_n, w_kv):
    bsz, seqlen, _ = xq.shape
    f32 = jnp.float32
    mk, mv = jnp.split(mem_n @ w_kv, 2, axis=-1)
    mk = mk.reshape(bsz, -1, XATTN_HEADS, XATTN_HEAD_DIM).astype(f32)
    mv = mv.reshape(bsz, -1, XATTN_HEADS, XATTN_HEAD_DIM).astype(f32)
    qh = xq.reshape(bsz, seqlen, XATTN_HEADS, XATTN_HEAD_DIM).astype(f32)
    logits = jnp.einsum('bqhd,bkhd->bhqk', qh, mk) * (XATTN_HEAD_DIM ** -0.5)
    probs = jax.nn.softmax(logits, axis=-1)
    out = jnp.einsum('bhqk,bkhd->bqhd', probs, mv)
    return out.reshape(bsz, seqlen, XATTN_WIDTH).astype(xq.dtype)


def hybrid_layer(x, mem, rel_table, ffn1_norm, ffn1_w_in, ffn1_w_down, mix_norm, w_in,
                 ssm_a_re, ssm_a_im, ssm_log_dt, ssm_b_re, ssm_b_im, ssm_c_re, ssm_c_im, ssm_d, ssm_w_glu,
                 attn_w_up, mem_norm, xattn_w_kv, xattn_w_up, w_out, ffn2_norm, ffn2_w_in, ffn2_w_down):
    bsz, seqlen, _ = x.shape
    x = x + 0.5 * swiglu_ffn(rmsnorm(x, ffn1_norm), ffn1_w_in, ffn1_w_down)
    u = rmsnorm(x, mix_norm)
    proj = u @ w_in
    cuts = np.cumsum([SSM_WIDTH, ATTN_WIDTH, ATTN_WIDTH, ATTN_WIDTH, XATTN_WIDTH, D_MODEL, D_MODEL]).tolist()
    u_ssm, q, k, v, xq, g_ssm, g_attn, g_mem = jnp.split(proj, cuts, axis=-1)
    y_ssm = jax.nn.gelu(s5_scan(u_ssm, ssm_a_re, ssm_a_im, ssm_log_dt, ssm_b_re, ssm_b_im,
                                ssm_c_re, ssm_c_im, ssm_d))
    glu_a, glu_b = jnp.split(y_ssm @ ssm_w_glu, 2, axis=-1)
    br_ssm = glu_a * jax.nn.sigmoid(glu_b)
    hshape = (bsz, seqlen, N_PATTERNS, HEADS_PER_PATTERN, HEAD_DIM)
    br_attn = dilated_mixture_attention(q.reshape(hshape), k.reshape(hshape), v.reshape(hshape),
                                        rel_table) @ attn_w_up
    br_mem = memory_cross_attention(xq, rmsnorm(mem, mem_norm), xattn_w_kv) @ xattn_w_up
    merged = (jax.nn.sigmoid(g_ssm) * br_ssm + jax.nn.sigmoid(g_attn) * br_attn
              + jax.nn.sigmoid(g_mem) * br_mem)
    x = x + merged @ w_out
    x = x + 0.5 * swiglu_ffn(rmsnorm(x, ffn2_norm), ffn2_w_in, ffn2_w_down)
    return x


def setup_inputs(seed: int = 0) -> dict:
    key = jax.random.key(seed)
    ks = jax.random.split(key, 32)
    f32 = jnp.float32

    def nrm(k, shape, fan_in):
        return jax.random.normal(k, shape, f32) * (fan_in ** -0.5)

    def gain(k, shape):
        return 1.0 + 0.02 * jax.random.normal(k, shape, f32)

    L = DEPTH
    a_im_init = jnp.pi * jnp.arange(SSM_STATE, dtype=f32)
    return {
        "x": jax.random.normal(ks[0], (BATCH, SEQ, D_MODEL), f32),
        "mem": jax.random.normal(ks[1], (BATCH, MEM_LEN, D_MODEL), f32),
        "ffn1_norm": gain(ks[2], (L, D_MODEL)),
        "ffn1_w_in": nrm(ks[3], (L, D_MODEL, 2 * D_FF), D_MODEL),
        "ffn1_w_down": nrm(ks[4], (L, D_FF, D_MODEL), D_FF),
        "mix_norm": gain(ks[5], (L, D_MODEL)),
        "w_in": nrm(ks[6], (L, D_MODEL, IN_WIDTH), D_MODEL),
        "ssm_a_re": -0.5 + 0.01 * jax.random.normal(ks[7], (L, SSM_GROUPS, SSM_STATE), f32),
        "ssm_a_im": a_im_init + 0.01 * jax.random.normal(ks[8], (L, SSM_GROUPS, SSM_STATE), f32),
        "ssm_log_dt": jax.random.uniform(ks[9], (L, SSM_GROUPS), f32,
                                         float(np.log(DT_MIN)), float(np.log(DT_MAX))),
        "ssm_b_re": nrm(ks[10], (L, SSM_GROUPS, SSM_STATE, SSM_GROUP), 2 * SSM_GROUP),
        "ssm_b_im": nrm(ks[11], (L, SSM_GROUPS, SSM_STATE, SSM_GROUP), 2 * SSM_GROUP),
        "ssm_c_re": nrm(ks[12], (L, SSM_GROUPS, SSM_GROUP, SSM_STATE), SSM_STATE),
        "ssm_c_im": nrm(ks[13], (L, SSM_GROUPS, SSM_GROUP, SSM_STATE), SSM_STATE),
        "ssm_d": jax.random.normal(ks[14], (L, SSM_GROUPS, SSM_GROUP), f32),
        "ssm_w_glu": nrm(ks[15], (L, SSM_WIDTH, 2 * D_MODEL), SSM_WIDTH),
        "rel_table": 0.5 * jax.random.normal(ks[16], (REL_BUCKETS, N_ATTN_HEADS), f32),
        "attn_w_up": nrm(ks[17], (L, ATTN_OUT_WIDTH, D_MODEL), ATTN_OUT_WIDTH),
        "mem_norm": gain(ks[18], (L, D_MODEL)),
        "xattn_w_kv": nrm(ks[19], (L, D_MODEL, 2 * XATTN_WIDTH), D_MODEL),
        "xattn_w_up": nrm(ks[20], (L, XATTN_WIDTH, D_MODEL), XATTN_WIDTH),
        "w_out": nrm(ks[21], (L, D_MODEL, D_MODEL), D_MODEL),
        "ffn2_norm": gain(ks[22], (L, D_MODEL)),
        "ffn2_w_in": nrm(ks[23], (L, D_MODEL, 2 * D_FF), D_MODEL),
        "ffn2_w_down": nrm(ks[24], (L, D_FF, D_MODEL), D_FF),
        "final_norm": gain(ks[25], (D_MODEL,)),
    }


def reference(x, mem, ffn1_norm, ffn1_w_in, ffn1_w_down, mix_norm, w_in,
              ssm_a_re, ssm_a_im, ssm_log_dt, ssm_b_re, ssm_b_im, ssm_c_re, ssm_c_im, ssm_d, ssm_w_glu,
              rel_table, attn_w_up, mem_norm, xattn_w_kv, xattn_w_up, w_out,
              ffn2_norm, ffn2_w_in, ffn2_w_down, final_norm):
    h = x
    for l in range(DEPTH):
        h = hybrid_layer(h, mem, rel_table, ffn1_norm[l], ffn1_w_in[l], ffn1_w_down[l], mix_norm[l], w_in[l],
                         ssm_a_re[l], ssm_a_im[l], ssm_log_dt[l], ssm_b_re[l], ssm_b_im[l],
                         ssm_c_re[l], ssm_c_im[l], ssm_d[l], ssm_w_glu[l],
                         attn_w_up[l], mem_norm[l], xattn_w_kv[l], xattn_w_up[l], w_out[l],
                         ffn2_norm[l], ffn2_w_in[l], ffn2_w_down[l])
    return rmsnorm(h, final_norm)
```

```cpp
#include <hip/hip_runtime.h>
#include <cstdio>
#include <cstdint>
#include <cmath>
namespace naive {
constexpr int D = 1024, SEQ = 8192, NB = 4, DFF = 2816, INW = 6400, MEML = 256;
constexpr float EPSN = 1e-6f;

__device__ const unsigned char BUCKETS[3][129] = {
{0,1,2,3,4,5,6,7,8,9,10,11,12,13,14,15,16,16,16,16,16,16,17,17,17,17,17,17,17,17,18,18,18,18,18,18,18,18,18,18,19,19,19,19,19,19,19,19,19,19,19,19,19,19,20,20,20,20,20,20,20,20,20,20,20,20,20,20,20,20,20,20,20,21,21,21,21,21,21,21,21,21,21,21,21,21,21,21,21,21,21,21,21,21,21,21,21,21,21,22,22,22,22,22,22,22,22,22,22,22,22,22,22,22,22,22,22,22,22,22,22,22,22,22,22,22,22,22,22},
{0,4,8,12,16,16,17,17,18,18,19,19,19,19,20,20,20,20,20,21,21,21,21,21,21,22,22,22,22,22,22,22,22,22,23,23,23,23,23,23,23,23,23,23,23,23,24,24,24,24,24,24,24,24,24,24,24,24,24,24,24,24,25,25,25,25,25,25,25,25,25,25,25,25,25,25,25,25,25,25,25,25,25,26,26,26,26,26,26,26,26,26,26,26,26,26,26,26,26,26,26,26,26,26,26,26,26,26,26,26,26,26,26,27,27,27,27,27,27,27,27,27,27,27,27,27,27,27,27},
{0,16,18,19,20,21,21,22,22,23,23,23,24,24,24,24,25,25,25,25,25,26,26,26,26,26,26,26,26,27,27,27,27,27,27,27,27,27,27,28,28,28,28,28,28,28,28,28,28,28,28,28,29,29,29,29,29,29,29,29,29,29,29,29,29,29,29,29,29,29,30,30,30,30,30,30,30,30,30,30,30,30,30,30,30,30,30,30,30,30,30,30,30,30,30,31,31,31,31,31,31,31,31,31,31,31,31,31,31,31,31,31,31,31,31,31,31,31,31,31,31,31,31,31,31,31,31,31,31}};

__device__ __forceinline__ float wsum(float v) {
#pragma unroll
    for (int o = 1; o < 64; o <<= 1) v += __shfl_xor(v, o);
    return v;
}
__device__ __forceinline__ float wmax(float v) {
#pragma unroll
    for (int o = 1; o < 64; o <<= 1) v = fmaxf(v, __shfl_xor(v, o));
    return v;
}
__global__ void k_rmsnorm(const float* x, const float* g, float* out, int rows) {
    int row = blockIdx.x * 4 + (threadIdx.x >> 6), lane = threadIdx.x & 63;
    if (row >= rows) return;
    const float* xr = x + (size_t)row * D; float v[16]; float s = 0.f;
#pragma unroll
    for (int j = 0; j < 16; ++j) { v[j] = xr[lane + 64 * j]; s += v[j] * v[j]; }
    s = wsum(s); float r = rsqrtf(s * (1.f / D) + EPSN);
#pragma unroll
    for (int j = 0; j < 16; ++j) out[(size_t)row * D + lane + 64 * j] = v[j] * r * g[lane + 64 * j];
}
__global__ void __launch_bounds__(256) k_gemm(const float* A, int lda, const float* W, int ldw, float* C, int ldc, int K) {
    __shared__ float As[16][65], Ws[16][64];
    int tx = threadIdx.x & 15, ty = threadIdx.x >> 4, m0 = blockIdx.y * 64, n0 = blockIdx.x * 64;
    float acc[4][4];
#pragma unroll
    for (int i = 0; i < 4; ++i)
#pragma unroll
        for (int j = 0; j < 4; ++j) acc[i][j] = 0.f;
    for (int k0 = 0; k0 < K; k0 += 16) {
#pragma unroll
        for (int i = 0; i < 4; ++i) { int e = threadIdx.x + 256 * i; int r = e >> 4, c = e & 15; As[c][r] = A[(size_t)(m0 + r) * lda + k0 + c]; }
#pragma unroll
        for (int i = 0; i < 4; ++i) { int e = threadIdx.x + 256 * i; int r = e >> 6, c = e & 63; Ws[r][c] = W[(size_t)(k0 + r) * ldw + n0 + c]; }
        __syncthreads();
#pragma unroll
        for (int k = 0; k < 16; ++k) {
            float a[4], b[4];
#pragma unroll
            for (int i = 0; i < 4; ++i) a[i] = As[k][ty * 4 + i];
#pragma unroll
            for (int j = 0; j < 4; ++j) b[j] = Ws[k][tx * 4 + j];
#pragma unroll
            for (int i = 0; i < 4; ++i)
#pragma unroll
                for (int j = 0; j < 4; ++j) acc[i][j] += a[i] * b[j];
        }
        __syncthreads();
    }
#pragma unroll
    for (int i = 0; i < 4; ++i)
#pragma unroll
        for (int j = 0; j < 4; ++j) C[(size_t)(m0 + ty * 4 + i) * ldc + n0 + tx * 4 + j] = acc[i][j];
}
__device__ __forceinline__ float sigm(float v) { return 1.f / (1.f + expf(-v)); }
__device__ __forceinline__ float gelu_tanh(float v) { return 0.5f * v * (1.f + tanhf(0.7978845608028654f * (v + 0.044715f * v * v * v))); }
__global__ void k_swiglu(const float* c, float* h, int rows) {
    size_t n = (size_t)rows * DFF;
    for (size_t i = blockIdx.x * (size_t)blockDim.x + threadIdx.x; i < n; i += (size_t)gridDim.x * blockDim.x) {
        size_t r = i / DFF; int j = (int)(i % DFF); float a = c[r * 2 * DFF + j], b = c[r * 2 * DFF + DFF + j]; h[i] = a * sigm(a) * b; }
}
__global__ void k_axpy(const float* base, const float* c, float alpha, float* out, size_t n) {
    for (size_t i = blockIdx.x * (size_t)blockDim.x + threadIdx.x; i < n; i += (size_t)gridDim.x * blockDim.x) out[i] = base[i] + alpha * c[i];
}
__global__ void __launch_bounds__(64) k_ssm(const float* proj, const float* a_re, const float* a_im, const float* log_dt, const float* b_re, const float* b_im,
                      const float* c_re, const float* c_im, const float* dsk, float* ys) {
    int g = blockIdx.x, p = threadIdx.x;
    double dt = exp((double)log_dt[g]); double ar = a_re[g * 64 + p], ai = a_im[g * 64 + p];
    double mag = exp(ar * dt), ang = ai * dt; double abr = mag * cos(ang), abi = mag * sin(ang);
    double nr = abr - 1.0, ni = abi, den = ar * ar + ai * ai; double cr = (nr * ar + ni * ai) / den, ci = (ni * ar - nr * ai) / den;
    float Br[16], Bi[16], Cr[16], Ci[16];
#pragma unroll
    for (int h = 0; h < 16; ++h) { double br = b_re[(g * 64 + p) * 16 + h], bi = b_im[(g * 64 + p) * 16 + h];
        Br[h] = (float)(cr * br - ci * bi); Bi[h] = (float)(cr * bi + ci * br); Cr[h] = c_re[(g * 16 + h) * 64 + p]; Ci[h] = c_im[(g * 16 + h) * 64 + p]; }
    float Ar = (float)abr, Ai = (float)abi, xr = 0.f, xi = 0.f; float dk = (p < 16) ? dsk[g * 16 + p] : 0.f;
    for (int t = 0; t < SEQ; ++t) {
        const float* u = proj + (size_t)t * INW + g * 16; float ur[16];
#pragma unroll
        for (int h = 0; h < 16; ++h) ur[h] = u[h];
        float bur = 0.f, bui = 0.f;
#pragma unroll
        for (int h = 0; h < 16; ++h) { bur += Br[h] * ur[h]; bui += Bi[h] * ur[h]; }
        float nxr = Ar * xr - Ai * xi + bur, nxi = Ar * xi + Ai * xr + bui; xr = nxr; xi = nxi;
        float mine = 0.f;
#pragma unroll
        for (int h = 0; h < 16; ++h) { float s = wsum(Cr[h] * xr - Ci[h] * xi); if (p == h) mine = s + dk * ur[h]; }
        if (p < 16) ys[(size_t)t * 512 + g * 16 + p] = gelu_tanh(mine);
    }
}
__global__ void __launch_bounds__(64) k_dattn(const float* proj, const float* rel, float* ao) {
    int idx = blockIdx.x * 64 + threadIdx.x; int l = idx >> 2, h = idx & 3;
    float m = -INFINITY, s = 0.f; float acc[64];
#pragma unroll
    for (int d = 0; d < 64; ++d) acc[d] = 0.f;
    for (int g = 0; g < 3; ++g) {
        int dil = (g == 0) ? 1 : (g == 1 ? 4 : 16);
        const float* qp = proj + (size_t)l * INW + 512 + g * 256 + h * 64; float q[64];
#pragma unroll
        for (int d = 0; d < 64; ++d) q[d] = qp[d];
        for (int j = 0; j <= 128; ++j) {
            int kp = l - j * dil; if (kp < 0) break;
            const float* kr = proj + (size_t)kp * INW + 1280 + g * 256 + h * 64; const float* vr = proj + (size_t)kp * INW + 2048 + g * 256 + h * 64;
            float dot = 0.f;
#pragma unroll
            for (int d = 0; d < 64; ++d) dot += q[d] * kr[d];
            float lg = dot * 0.125f + rel[(int)BUCKETS[g][j] * 12 + g * 4 + h];
            float mn = fmaxf(m, lg); float f = expf(m - mn), pe = expf(lg - mn); s = s * f + pe;
#pragma unroll
            for (int d = 0; d < 64; ++d) acc[d] = acc[d] * f + pe * vr[d];
            m = mn;
        }
    }
    float inv = 1.f / s;
#pragma unroll
    for (int d = 0; d < 64; ++d) ao[(size_t)l * 256 + h * 64 + d] = acc[d] * inv;
}
__global__ void __launch_bounds__(256) k_xattn(const float* proj, const float* mkv, float* xo) {
    int w = blockIdx.x * 4 + (threadIdx.x >> 6), lane = threadIdx.x & 63; int l = w >> 2, hd = w & 3;
    const float* qp = proj + (size_t)l * INW + 2816 + hd * 128;
    float lg[4];
#pragma unroll
    for (int i = 0; i < 4; ++i) { const float* kr = mkv + (size_t)(lane + 64 * i) * 1024 + hd * 128; float dot = 0.f;
        for (int d = 0; d < 128; ++d) dot += qp[d] * kr[d];
        lg[i] = dot * 0.08838834764831845f; }
    float m = wmax(fmaxf(fmaxf(lg[0], lg[1]), fmaxf(lg[2], lg[3])));
    float pe[4]; float s = 0.f;
#pragma unroll
    for (int i = 0; i < 4; ++i) { pe[i] = expf(lg[i] - m); s += pe[i]; }
    s = wsum(s); float inv = 1.f / s;
    float o0 = 0.f, o1 = 0.f;
#pragma unroll
    for (int i = 0; i < 4; ++i)
        for (int kk = 0; kk < 64; ++kk) { float pv = __shfl(pe[i], kk); const float* vr = mkv + (size_t)(kk + 64 * i) * 1024 + 512 + hd * 128; o0 += pv * vr[lane]; o1 += pv * vr[lane + 64]; }
    xo[(size_t)l * 512 + hd * 128 + lane] = o0 * inv; xo[(size_t)l * 512 + hd * 128 + lane + 64] = o1 * inv;
}
__global__ void k_merge(const float* proj, int goff, const float* br, int ldb, int glu, int accum, float* merged, int rows) {
    size_t n = (size_t)rows * D;
    for (size_t i = blockIdx.x * (size_t)blockDim.x + threadIdx.x; i < n; i += (size_t)gridDim.x * blockDim.x) {
        size_t r = i / D; int c = (int)(i % D); float v = br[r * ldb + c]; if (glu) v *= sigm(br[r * ldb + 1024 + c]);
        float o = sigm(proj[r * INW + goff + c]) * v; merged[i] = accum ? merged[i] + o : o; }
}

struct Bufs { float *un, *c1, *hb, *c2, *proj, *ys, *glu, *ao, *xo, *br, *merged, *memn, *mkv; };

static void gemm(hipStream_t st, const float* A, int lda, const float* W, int ldw, float* C, int ldc, int M, int N, int K) {
    hipLaunchKernelGGL(k_gemm, dim3(N / 64, M / 64), dim3(256), 0, st, A, lda, W, ldw, C, ldc, K);
}
static void ffn(hipStream_t st, const Bufs& B, const float* xin, float* xout, const float* nrm, const float* win, const float* wdn) {
    hipLaunchKernelGGL(k_rmsnorm, dim3(SEQ / 4), dim3(256), 0, st, xin, nrm, B.un, SEQ);
    gemm(st, B.un, D, win, 2 * DFF, B.c1, 2 * DFF, SEQ, 2 * DFF, D);
    hipLaunchKernelGGL(k_swiglu, dim3(2048), dim3(256), 0, st, (const float*)B.c1, B.hb, SEQ);
    gemm(st, B.hb, DFF, wdn, D, B.c2, D, SEQ, D, DFF);
    hipLaunchKernelGGL(k_axpy, dim3(2048), dim3(256), 0, st, xin, (const float*)B.c2, 0.5f, xout, (size_t)SEQ * D);
}
static void forward(void* const* d_in, float* out, void* d_ws, hipStream_t st) {
    const float* const* in = (const float* const*)d_in;
    char* w = (char*)d_ws; size_t MiB = 1u << 20; Bufs B;
    B.un = (float*)(w + 0 * MiB);
    B.c2 = (float*)(w + 32 * MiB);
    B.c1 = (float*)(w + 64 * MiB);
    B.proj = B.c1;
    B.hb = (float*)(w + 264 * MiB);
    B.ys = B.hb;
    B.ao = (float*)(w + 280 * MiB);
    B.xo = (float*)(w + 288 * MiB);
    B.glu = (float*)(w + 352 * MiB);
    B.br = B.glu;
    B.merged = (float*)(w + 304 * MiB);
    B.memn = (float*)(w + 336 * MiB);
    B.mkv = (float*)(w + 338 * MiB);
    for (int b = 0; b < NB; ++b) {
        const float* xin = in[0] + (size_t)b * SEQ * D; float* xc = out + (size_t)b * SEQ * D;
        ffn(st, B, xin, xc, in[2], in[3], in[4]);
        hipLaunchKernelGGL(k_rmsnorm, dim3(SEQ / 4), dim3(256), 0, st, (const float*)xc, in[5], B.un, SEQ);
        gemm(st, B.un, D, in[6], INW, B.proj, INW, SEQ, INW, D);
        hipLaunchKernelGGL(k_ssm, dim3(32), dim3(64), 0, st, (const float*)B.proj, in[7], in[8], in[9], in[10], in[11], in[12], in[13], in[14], B.ys);
        gemm(st, B.ys, 512, in[15], 2048, B.glu, 2048, SEQ, 2048, 512);
        hipLaunchKernelGGL(k_merge, dim3(2048), dim3(256), 0, st, (const float*)B.proj, 3328, (const float*)B.glu, 2048, 1, 0, B.merged, SEQ);
        hipLaunchKernelGGL(k_dattn, dim3(SEQ * 4 / 64), dim3(64), 0, st, (const float*)B.proj, in[16], B.ao);
        gemm(st, B.ao, 256, in[17], D, B.br, D, SEQ, D, 256);
        hipLaunchKernelGGL(k_merge, dim3(2048), dim3(256), 0, st, (const float*)B.proj, 4352, (const float*)B.br, D, 0, 1, B.merged, SEQ);
        hipLaunchKernelGGL(k_rmsnorm, dim3(MEML / 4), dim3(256), 0, st, in[1] + (size_t)b * MEML * D, in[18], B.memn, MEML);
        gemm(st, B.memn, D, in[19], 1024, B.mkv, 1024, MEML, 1024, D);
        hipLaunchKernelGGL(k_xattn, dim3(SEQ * 4 / 4), dim3(256), 0, st, (const float*)B.proj, (const float*)B.mkv, B.xo);
        gemm(st, B.xo, 512, in[20], D, B.br, D, SEQ, D, 512);
        hipLaunchKernelGGL(k_merge, dim3(2048), dim3(256), 0, st, (const float*)B.proj, 5376, (const float*)B.br, D, 0, 1, B.merged, SEQ);
        gemm(st, B.merged, D, in[21], D, B.c2, D, SEQ, D, D);
        hipLaunchKernelGGL(k_axpy, dim3(2048), dim3(256), 0, st, (const float*)xc, (const float*)B.c2, 1.0f, xc, (size_t)SEQ * D);
        ffn(st, B, xc, xc, in[22], in[23], in[24]);
        hipLaunchKernelGGL(k_rmsnorm, dim3(SEQ / 4), dim3(256), 0, st, (const float*)xc, in[25], xc, SEQ);
    }
}
}
extern "C" void kernel_launch(void* const* d_in, const int* in_sizes, int n_in, void* d_out, int out_size, void* d_ws, size_t ws_size, hipStream_t stream) {
    if (n_in != 26 || ws_size < (size_t)420 * 1048576) { fprintf(stderr, "kernel_launch: unexpected n_in %d / ws %zu\n", n_in, ws_size); return; }
    naive::forward(d_in, (float*)d_out, d_ws, stream);
}
```

```cpp
#include <hip/hip_runtime.h>
#include <cstdio>
#include <cstdint>
#include <cmath>
#define MK_MULTI 1
#define LAS __attribute__((address_space(3)))
#define GAS __attribute__((address_space(1)))
typedef unsigned short bf16_t;
typedef short bf16x8 __attribute__((ext_vector_type(8)));
typedef short s16x4 __attribute__((ext_vector_type(4)));
typedef float f32x4 __attribute__((ext_vector_type(4)));
typedef float f32x2 __attribute__((ext_vector_type(2)));
typedef float f32x16 __attribute__((ext_vector_type(16)));
typedef unsigned u32x4 __attribute__((ext_vector_type(4)));
typedef unsigned u32x2 __attribute__((ext_vector_type(2)));

constexpr int D_MODEL = 1024, NBATCH = 4, SEQ = 8192, MTOK = NBATCH * SEQ;
constexpr int D_FF = 2816, IN_WIDTH = 6400, MEM_LEN = 256, MEMROWS = NBATCH * MEM_LEN;
constexpr float EPS = 1e-6f;
constexpr float LOG2E = 1.4426950408889634f;

__device__ __forceinline__ unsigned cvt_pk_bf16(float lo, float hi) { unsigned r; asm volatile("v_cvt_pk_bf16_f32 %0, %1, %2" : "=v"(r) : "v"(lo), "v"(hi)); return r; }
__device__ __forceinline__ float bf_lo(unsigned w) { return __uint_as_float(w << 16); }
__device__ __forceinline__ float bf_hi(unsigned w) { return __uint_as_float(w & 0xffff0000u); }
__device__ __forceinline__ float fast_sigmoid(float v) { return __builtin_amdgcn_rcpf(1.f + __builtin_amdgcn_exp2f(-v * LOG2E)); }
__device__ __forceinline__ float gelu_tanh_f(float v) { const float z = 0.7978845608028654f * (v + 0.044715f * v * v * v); return v * __builtin_amdgcn_rcpf(1.f + __builtin_amdgcn_exp2f(-2.f * LOG2E * z)); }
__device__ __forceinline__ float wave_sum(float v) {
#pragma unroll
    for (int o = 1; o < 64; o <<= 1) v += __shfl_xor(v, o);
    return v;
}

constexpr size_t KiB = 1024;
constexpr size_t WS_CTL = 0;
constexpr size_t WS_SS1 = 64 * KiB;
constexpr size_t WS_SS2 = WS_SS1 + 128 * KiB;
constexpr size_t WS_SS3 = WS_SS2 + 512 * KiB;
constexpr size_t WS_SS4 = WS_SS3 + 512 * KiB;
constexpr size_t WS_SSM = WS_SS4 + 512 * KiB;
constexpr size_t WS_MEMB = 1792 * KiB;
constexpr size_t WS_MEMKV = WS_MEMB + 2048 * KiB;
constexpr size_t WS_WIN = WS_MEMKV + 2048 * KiB;
constexpr size_t WS_WGLU = WS_WIN + 12800 * KiB;
constexpr size_t WS_WAU = WS_WGLU + 2048 * KiB;
constexpr size_t WS_WKV = WS_WAU + 512 * KiB;
constexpr size_t WS_WMU = WS_WKV + 2048 * KiB;
constexpr size_t WS_WOUT = WS_WMU + 1024 * KiB;
constexpr size_t WS_WFIN = WS_WOUT + 2048 * KiB;
constexpr size_t WS_WFDN = WS_WFIN + 11264 * KiB;
constexpr size_t WS_XB = WS_WFDN + 5632 * KiB;
constexpr size_t WS_LP = WS_XB;
constexpr size_t WS_QT = WS_LP + 24576 * KiB;
constexpr size_t WS_SLOC = WS_QT + 8192 * KiB;
constexpr size_t WS_LSE = WS_SLOC + 8192 * KiB;
constexpr size_t WS_BIG = WS_XB + 65536 * KiB;
constexpr size_t WS_H = WS_BIG;
constexpr size_t WS_QKV = WS_BIG;
constexpr size_t WS_XQ = WS_QKV + 147456 * KiB;
constexpr size_t WS_AG = WS_XQ + 32768 * KiB;
constexpr size_t WS_GATE = WS_AG + 36864 * KiB;
constexpr size_t WS_END = WS_GATE + 3 * 65536 * KiB;
static_assert(WS_SSM + 4 * KiB <= WS_MEMB, "ws map");
static_assert(WS_LSE + 1536 * KiB <= WS_BIG, "ws map");
static_assert(WS_END <= (size_t)512 * 1024 * KiB, "ws map exceeds 512 MiB");
constexpr int QKV_PITCH = 2304, AG_PITCH = 1152, LP_PITCH = 1536;
namespace g8 {
constexpr int BM = 256, BK = 64, HALF = 128, HTB = HALF * BK * 2, STAGE_BYTES = 8 * HTB;

__host__ __device__ __forceinline__ int lds_byte(int r, int c) { const int st = (r >> 4) * 2 + (c >> 5), rr = r & 15, cc = c & 31, ob = rr * 64 + cc * 2; return st * 1024 + (ob ^ (((ob >> 9) & 1) << 5)); }
__host__ __device__ __forceinline__ void stage_rc(int b, int& R, int& C) { const int st = b / 1024, sb = b % 1024, swz = sb ^ (((sb >> 9) & 1) << 5); R = (st >> 1) * 16 + swz / 64; C = (st & 1) * 32 + (swz % 64) / 2; }
__host__ __device__ __forceinline__ int perm32(int rho) { const int n = rho >> 4, i = rho & 15; return 8 * (i >> 2) + 4 * n + (i & 3); }

struct Unit { const char* A; const char* B; int pm, pn, aux, nt, nt1, jumpA, jumpB; };
struct Cfg { int lda, ldb; size_t hstepA, hstepB; };

__device__ __forceinline__ void decode_tile(int L, int nM, int nN, int& pm, int& pn) {
    const int nwg = nM * nN; int wgid = L;
    { const int q = nwg / 8, r = nwg % 8, xcd = wgid % 8, off = wgid / 8; wgid = (xcd < r ? xcd * (q + 1) : r * (q + 1) + (xcd - r) * q) + off; }
    const int nig = 8 * nN, gid = wgid / nig, fm = gid * 8, gsz = (nM - fm) < 8 ? (nM - fm) : 8;
    pm = fm + ((wgid % nig) % gsz); pn = (wgid % nig) / gsz;
}

template <class Epi, class Sched, bool JUMP>
__device__ __forceinline__ void gemm_phase(LAS unsigned char* lds, const Cfg cfg, const Sched& S, const Epi& E) {
    const int tid = threadIdx.x, wid = __builtin_amdgcn_readfirstlane(tid >> 6), lane = tid & 63, wr = wid >> 2, wc = wid & 3, fr = lane & 15, fq = lane >> 4;
    unsigned voffA[2], voffB[2];
#pragma unroll
    for (int i = 0; i < 2; ++i) { int R, C; stage_rc(tid * 16 + i * 8192, R, C); const int Rb = Epi::PERM ? ((R & ~31) + perm32(R & 31)) : R;
        voffA[i] = (unsigned)(R * cfg.lda + C) * 2u; voffB[i] = (unsigned)(Rb * cfg.ldb + C) * 2u; }
    const size_t kstep = (size_t)(BK * 2);
    const size_t hsA = cfg.hstepA, hsB = cfg.hstepB;
    const unsigned ldsw = (unsigned)wid * 1024u;
    const int aoff = lds_byte(wr * 64 + fr, fq * 8), boff = lds_byte(wc * 32 + fr, fq * 8);
#define G8_SA(b, h) (((b) * 2 + (h)) * HTB)
#define G8_SB(b, h) ((4 + (b) * 2 + (h)) * HTB)
#define G8_STAGE(bufoff, gbase, voff) do { _Pragma("unroll") for (int _i = 0; _i < 2; ++_i) \
        __builtin_amdgcn_global_load_lds((const unsigned*)((const char*)(gbase) + (voff)[_i]), (LAS unsigned*)(lds + (bufoff) + ldsw + _i * 8192), 16, 0, 0); } while (0)
#define G8_LDA(dst, b, h) do { _Pragma("unroll") for (int m = 0; m < 4; ++m) _Pragma("unroll") for (int k = 0; k < 2; ++k) dst[m][k] = *(const LAS bf16x8*)(lds + G8_SA(b, h) + aoff + m * 2048 + k * 1024); } while (0)
#define G8_LDB(dst, b, h) do { _Pragma("unroll") for (int n = 0; n < 2; ++n) _Pragma("unroll") for (int k = 0; k < 2; ++k) dst[n][k] = *(const LAS bf16x8*)(lds + G8_SB(b, h) + boff + n * 2048 + k * 1024); } while (0)
#define G8_MMA(ai, bj, At, Bt) do { __builtin_amdgcn_s_setprio(1); _Pragma("unroll") for (int m = 0; m < 4; ++m) _Pragma("unroll") for (int n = 0; n < 2; ++n) _Pragma("unroll") for (int k = 0; k < 2; ++k) \
        acc[ai][bj][m][n] = __builtin_amdgcn_mfma_f32_16x16x32_bf16(Bt[n][k], At[m][k], acc[ai][bj][m][n], 0, 0, 0); __builtin_amdgcn_s_setprio(0); } while (0)
#define G8_WAIT_V(n) asm volatile("s_waitcnt vmcnt(" #n ")" ::: "memory")
#define G8_WAIT_L(n) asm volatile("s_waitcnt lgkmcnt(" #n ")" ::: "memory")
#define G8_BAR __builtin_amdgcn_s_barrier()
#define G8_SCHED __builtin_amdgcn_sched_barrier(0)
#define G8_KA(u, t) ((size_t)(t) * kstep + ((JUMP && (t) >= (u).nt1) ? (size_t)(long)(u).jumpA : (size_t)0))
#define G8_KB(u, t) ((size_t)(t) * kstep + ((JUMP && (t) >= (u).nt1) ? (size_t)(long)(u).jumpB : (size_t)0))
    Unit cur, nxt; int ui = 0;
    if (!S.next(0, cur)) return;
    f32x4 acc[2][2][4][2];
#pragma unroll
    for (int a = 0; a < 2; ++a)
#pragma unroll
        for (int b = 0; b < 2; ++b)
#pragma unroll
            for (int m = 0; m < 4; ++m)
#pragma unroll
                for (int n = 0; n < 2; ++n) acc[a][b][m][n] = (f32x4){0.f, 0.f, 0.f, 0.f};
    bf16x8 At[4][2], B0[2][2], B1[2][2];
    const char* cA = cur.A; const char* cB = cur.B;
    G8_STAGE(G8_SB(0, 0), cB, voffB); G8_STAGE(G8_SB(0, 1), cB + hsB, voffB); G8_STAGE(G8_SA(0, 0), cA, voffA); G8_STAGE(G8_SA(0, 1), cA + hsA, voffA);
    if (wr == 1) G8_BAR;
    G8_WAIT_V(2); G8_BAR;
    G8_STAGE(G8_SB(1, 0), cB + kstep, voffB); G8_STAGE(G8_SA(1, 0), cA + kstep, voffA); G8_STAGE(G8_SB(1, 1), cB + hsB + kstep, voffB);
    G8_WAIT_V(6); G8_BAR;
    for (;;) {
        const bool has_next = S.next(ui + 1, nxt);
        const char* nA = has_next ? nxt.A : cA; const char* nB = has_next ? nxt.B : cB;
        const int nt = cur.nt;
        for (int t = 0; t < nt; t += 2) {
            const bool last = (t == nt - 2);
            const char* a1 = cA + G8_KA(cur, t + 1);
            const char* a2 = last ? nA : cA + G8_KA(cur, t + 2); const char* b2 = last ? nB : cB + G8_KB(cur, t + 2);
            const char* a3 = last ? nA + kstep : cA + G8_KA(cur, t + 3); const char* b3 = last ? nB + kstep : cB + G8_KB(cur, t + 3);
            G8_LDB(B0, 0, 0); G8_LDB(B1, 0, 1); G8_SCHED; G8_LDA(At, 0, 0); G8_STAGE(G8_SA(1, 1), a1 + hsA, voffA);
            G8_WAIT_V(8); G8_WAIT_L(0); G8_BAR; G8_MMA(0, 0, At, B0); G8_MMA(0, 1, At, B1); G8_BAR; G8_SCHED;
            G8_LDA(At, 0, 1); G8_STAGE(G8_SB(0, 0), b2, voffB); G8_STAGE(G8_SB(0, 1), b2 + hsB, voffB); G8_STAGE(G8_SA(0, 0), a2, voffA);
            G8_WAIT_V(8); G8_WAIT_L(0); G8_BAR; G8_MMA(1, 0, At, B0); G8_MMA(1, 1, At, B1); G8_BAR; G8_SCHED;
            G8_LDB(B0, 1, 0); G8_LDB(B1, 1, 1); G8_SCHED; G8_LDA(At, 1, 0); G8_STAGE(G8_SA(0, 1), a2 + hsA, voffA);
            G8_WAIT_V(8); G8_WAIT_L(0); G8_BAR; G8_MMA(0, 0, At, B0); G8_MMA(0, 1, At, B1); G8_BAR; G8_SCHED;
            G8_LDA(At, 1, 1); G8_STAGE(G8_SB(1, 0), b3, voffB); G8_STAGE(G8_SB(1, 1), b3 + hsB, voffB); G8_STAGE(G8_SA(1, 0), a3, voffA);
            G8_WAIT_V(8); G8_WAIT_L(0); G8_BAR; G8_MMA(1, 0, At, B0); G8_MMA(1, 1, At, B1); G8_BAR; G8_SCHED;
        }
        if (wr == 0) G8_BAR;
        E(acc, cur, wr, wc, fr, fq, lds);
        if (!has_next) break;
#pragma unroll
        for (int a = 0; a < 2; ++a)
#pragma unroll
            for (int b = 0; b < 2; ++b)
#pragma unroll
                for (int m = 0; m < 4; ++m)
#pragma unroll
                    for (int n = 0; n < 2; ++n) acc[a][b][m][n] = (f32x4){0.f, 0.f, 0.f, 0.f};
        cur = nxt; cA = nA; cB = nB; ++ui;
        if (wr == 1) G8_BAR;
    }
    G8_WAIT_V(0);
    G8_BAR;
#undef G8_SA
#undef G8_SB
#undef G8_STAGE
#undef G8_LDA
#undef G8_LDB
#undef G8_MMA
#undef G8_WAIT_V
#undef G8_WAIT_L
#undef G8_BAR
#undef G8_SCHED
#undef G8_KA
#undef G8_KB
}
}
namespace g8 {
constexpr int EPI_SCR = STAGE_BYTES;

__device__ __forceinline__ float row_rstd(const float* ss, int nparts, int stride, int row) {
    float s = ss[row];
    for (int i = 1; i < nparts; ++i) s += ss[(size_t)i * stride + row];
    return rsqrtf(s * (1.f / D_MODEL) + EPS);
}

struct EpiSwiglu {
    static constexpr bool PERM = true;
    bf16_t* H; const float* ss; int nparts;
    __device__ __forceinline__ void operator()(const f32x4 (&acc)[2][2][4][2], const Unit& u, int wr, int wc, int fr, int fq, LAS unsigned char*) const {
#pragma unroll
        for (int ai = 0; ai < 2; ++ai)
#pragma unroll
            for (int m = 0; m < 4; ++m) {
                const int row = u.pm * BM + ai * HALF + wr * 64 + m * 16 + fr;
                const float r = row_rstd(ss, nparts, MTOK, row);
                float hv[8];
#pragma unroll
                for (int n = 0; n < 2; ++n)
#pragma unroll
                    for (int j = 0; j < 4; ++j) { const float a = acc[ai][0][m][n][j] * r, b = acc[ai][1][m][n][j] * r; hv[n * 4 + j] = a * fast_sigmoid(a) * b; }
                u32x4 w; w.x = cvt_pk_bf16(hv[0], hv[1]); w.y = cvt_pk_bf16(hv[2], hv[3]); w.z = cvt_pk_bf16(hv[4], hv[5]); w.w = cvt_pk_bf16(hv[6], hv[7]);
                *(u32x4*)(H + (size_t)row * D_FF + u.pn * 128 + wc * 32 + fq * 8) = w;
            }
    }
};

struct EpiResid {
    static constexpr bool PERM = false;
    const float* xres; float* xout; bf16_t* xb; float* ssout; float alpha;
    __device__ __forceinline__ void operator()(const f32x4 (&acc)[2][2][4][2], const Unit& u, int wr, int wc, int fr, int fq, LAS unsigned char* lds) const {
        LAS float* scr = (LAS float*)(lds + EPI_SCR);
#pragma unroll
        for (int ai = 0; ai < 2; ++ai)
#pragma unroll
            for (int m = 0; m < 4; ++m) {
                const int lrow = ai * HALF + wr * 64 + m * 16 + fr; const size_t row = (size_t)u.pm * BM + lrow;
                float sq = 0.f;
#pragma unroll
                for (int bj = 0; bj < 2; ++bj)
#pragma unroll
                    for (int n = 0; n < 2; ++n) {
                        const size_t off = row * D_MODEL + u.pn * BM + bj * HALF + wc * 32 + n * 16 + fq * 4;
                        const f32x4 xr = *(const f32x4*)(xres + off); f32x4 o = xr + acc[ai][bj][m][n] * alpha;
                        *(f32x4*)(xout + off) = o; sq += (o[0] * o[0] + o[1] * o[1]) + (o[2] * o[2] + o[3] * o[3]);
                        u32x2 w; w.x = cvt_pk_bf16(o[0], o[1]); w.y = cvt_pk_bf16(o[2], o[3]); *(u32x2*)(xb + off) = w;
                    }
                sq += __shfl_xor(sq, 16); sq += __shfl_xor(sq, 32);
                if (fq == 0) scr[lrow * 4 + wc] = sq;
            }
        asm volatile("s_waitcnt lgkmcnt(0)" ::: "memory"); __builtin_amdgcn_s_barrier(); asm volatile("" ::: "memory");
        if (threadIdx.x < 256) { const int lrow = threadIdx.x; const f32x4 p = *(const LAS f32x4*)(scr + lrow * 4);
            ssout[(size_t)u.pn * MTOK + (size_t)u.pm * BM + lrow] = (p[0] + p[1]) + (p[2] + p[3]); }
        asm volatile("s_waitcnt lgkmcnt(0)" ::: "memory"); __builtin_amdgcn_s_barrier(); asm volatile("" ::: "memory");
    }
};

struct EpiProj {
    static constexpr bool PERM = true;
    const float* ss2; const float* ssm; bf16_t *AG, *QKV, *XQ, *GATE, *MEMKV;
    __device__ __forceinline__ void operator()(const f32x4 (&acc)[2][2][4][2], const Unit& u, int wr, int wc, int fr, int fq, LAS unsigned char*) const {
        const int pn = u.pn; const bool is_mem = (u.aux != 0);
        int kind; bf16_t* dst; int pitch; float scale = 1.f;
        if (is_mem) { kind = 0; dst = MEMKV + pn * 256; pitch = 1024; }
        else if (pn < 2) { kind = 2; dst = AG; pitch = 0; }
        else if (pn < 11) { kind = 0; dst = QKV + (pn - 2) * 256; pitch = QKV_PITCH; if (pn < 5) scale = 0.125f * LOG2E; }
        else if (pn < 13) { kind = 0; dst = XQ + (pn - 11) * 256; pitch = 512; scale = 0.08838834764831845f * LOG2E; }
        else { kind = 1; const int gi = (pn - 13) >> 2; dst = GATE + (size_t)gi * MTOK * D_MODEL + ((pn - 13) & 3) * 256; pitch = 1024; }
#pragma unroll
        for (int ai = 0; ai < 2; ++ai)
#pragma unroll
            for (int m = 0; m < 4; ++m) {
                const int row = u.pm * BM + ai * HALF + wr * 64 + m * 16 + fr;
                const float r = (is_mem ? rsqrtf(ssm[row] * (1.f / D_MODEL) + EPS) : row_rstd(ss2, 4, MTOK, row)) * scale;
#pragma unroll
                for (int bj = 0; bj < 2; ++bj) {
                    float v[8];
#pragma unroll
                    for (int n = 0; n < 2; ++n)
#pragma unroll
                        for (int j = 0; j < 4; ++j) { float x = acc[ai][bj][m][n][j] * r; if (kind == 1) x = fast_sigmoid(x); v[n * 4 + j] = x; }
                    u32x4 w; w.x = cvt_pk_bf16(v[0], v[1]); w.y = cvt_pk_bf16(v[2], v[3]); w.z = cvt_pk_bf16(v[4], v[5]); w.w = cvt_pk_bf16(v[6], v[7]);
                    const int col = bj * HALF + wc * 32 + fq * 8;
                    bf16_t* p;
                    if (kind == 2) { const int ch = pn * 256 + col, g = ch >> 4, h0 = ch & 15; const int b = row >> 13, l = row & 8191, c = l >> 6, t = l & 63;
                        p = AG + ((size_t)(g * 512 + b * 128 + c) * AG_PITCH + t * 16 + h0); }
                    else p = dst + (size_t)row * pitch + col;
                    *(u32x4*)p = w;
                }
            }
    }
};

struct EpiSloc {
    static constexpr bool PERM = false;
    float* SLOC;
    __device__ __forceinline__ void operator()(const f32x4 (&acc)[2][2][4][2], const Unit& u, int wr, int wc, int fr, int fq, LAS unsigned char*) const {
#pragma unroll
        for (int ai = 0; ai < 2; ++ai)
#pragma unroll
            for (int m = 0; m < 4; ++m) {
                const int row = u.pm * BM + ai * HALF + wr * 64 + m * 16 + fr;
#pragma unroll
                for (int n = 0; n < 2; ++n) *(f32x4*)(SLOC + (size_t)row * 128 + wc * 32 + n * 16 + fq * 4) = acc[ai][0][m][n];
            }
    }
};

struct EpiY {
    static constexpr bool PERM = true;
    bf16_t* Y;
    __device__ __forceinline__ void operator()(const f32x4 (&acc)[2][2][4][2], const Unit& u, int wr, int wc, int fr, int fq, LAS unsigned char*) const {
        const int g = u.pm >> 1, rt = u.pm & 1, j = u.pn;
#pragma unroll
        for (int ai = 0; ai < 2; ++ai)
#pragma unroll
            for (int m = 0; m < 4; ++m) {
                const int r = rt * 256 + ai * HALF + wr * 64 + m * 16 + fr; const int b = r >> 7, c = r & 127;
#pragma unroll
                for (int bj = 0; bj < 2; ++bj) {
                    const int col = bj * HALF + wc * 32 + fq * 8, tl = col >> 4, h0 = col & 15; const int tok = b * SEQ + c * 64 + j * 16 + tl;
                    float v[8];
#pragma unroll
                    for (int n = 0; n < 2; ++n)
#pragma unroll
                        for (int q = 0; q < 4; ++q) v[n * 4 + q] = gelu_tanh_f(acc[ai][bj][m][n][q]);
                    u32x4 w; w.x = cvt_pk_bf16(v[0], v[1]); w.y = cvt_pk_bf16(v[2], v[3]); w.z = cvt_pk_bf16(v[4], v[5]); w.w = cvt_pk_bf16(v[6], v[7]);
                    *(u32x4*)(Y + (size_t)tok * QKV_PITCH + g * 16 + h0) = w;
                }
            }
    }
};

template <int MODE> struct EpiMerge {
    static constexpr bool PERM = true;
    const bf16_t* gate; bf16_t* merged;
    __device__ __forceinline__ void operator()(const f32x4 (&acc)[2][2][4][2], const Unit& u, int wr, int wc, int fr, int fq, LAS unsigned char*) const {
#pragma unroll
        for (int ai = 0; ai < 2; ++ai)
#pragma unroll
            for (int m = 0; m < 4; ++m) {
                const size_t row = (size_t)u.pm * BM + ai * HALF + wr * 64 + m * 16 + fr;
#pragma unroll
                for (int bj = 0; bj < (MODE == 2 ? 1 : 2); ++bj) {
                    const size_t off = row * D_MODEL + (MODE == 2 ? u.pn * 128 : u.pn * BM + bj * HALF) + wc * 32 + fq * 8;
                    float v[8];
#pragma unroll
                    for (int n = 0; n < 2; ++n)
#pragma unroll
                        for (int q = 0; q < 4; ++q) v[n * 4 + q] = (MODE == 2) ? acc[ai][0][m][n][q] * fast_sigmoid(acc[ai][1][m][n][q]) : acc[ai][bj][m][n][q];
                    const u32x4 gw = *(const u32x4*)(gate + off);
                    float o[8];
#pragma unroll
                    for (int q = 0; q < 4; ++q) { o[2 * q] = bf_lo(gw[q]) * v[2 * q]; o[2 * q + 1] = bf_hi(gw[q]) * v[2 * q + 1]; }
                    if (MODE != 0) { const u32x4 mw = *(const u32x4*)(merged + off);
#pragma unroll
                        for (int q = 0; q < 4; ++q) { o[2 * q] += bf_lo(mw[q]); o[2 * q + 1] += bf_hi(mw[q]); } }
                    u32x4 w; w.x = cvt_pk_bf16(o[0], o[1]); w.y = cvt_pk_bf16(o[2], o[3]); w.z = cvt_pk_bf16(o[4], o[5]); w.w = cvt_pk_bf16(o[6], o[7]);
                    *(u32x4*)(merged + off) = w;
                }
            }
    }
};

struct OrdDense {
    const char* A; const char* B; int nM, nN, nt, G, c; size_t tstepA, tstepB;
    __device__ __forceinline__ bool next(int i, Unit& u) const {
        const long L = (long)i * G + c; if (L >= (long)nM * nN) return false;
        decode_tile((int)L, nM, nN, u.pm, u.pn); u.A = A + (size_t)u.pm * tstepA; u.B = B + (size_t)u.pn * tstepB; u.aux = 0; u.nt = nt; u.nt1 = nt; u.jumpA = 0; u.jumpB = 0; return true;
    }
};
struct OrdProj {
    const char *A, *B, *Am, *Bm; int G, c;
    __device__ __forceinline__ bool next(int i, Unit& u) const {
        const long L = (long)i * G + c; u.nt = 16; u.nt1 = 16; u.jumpA = 0; u.jumpB = 0;
        if (L < 3200) { decode_tile((int)L, 128, 25, u.pm, u.pn); u.A = A + (size_t)u.pm * (256 * 1024 * 2); u.B = B + (size_t)u.pn * (256 * 1024 * 2); u.aux = 0; return true; }
        if (L < 3216) { const int x = (int)L - 3200; u.pm = x >> 2; u.pn = x & 3; u.A = Am + (size_t)u.pm * (256 * 1024 * 2); u.B = Bm + (size_t)u.pn * (256 * 1024 * 2); u.aux = 1; return true; }
        return false;
    }
};
struct OrdSloc {
    const char *AG, *QT; int G, c;
    __device__ __forceinline__ bool next(int i, Unit& u) const {
        const long L = (long)i * G + c; if (L >= 64) return false;
        u.pm = (int)L; u.pn = 0; u.A = AG + (size_t)u.pm * (256 * AG_PITCH * 2); u.B = QT + (size_t)(u.pm >> 1) * (128 * 1024 * 2); u.aux = 0; u.nt = 16; u.nt1 = 16; u.jumpA = 0; u.jumpB = 0; return true;
    }
};
struct OrdY {
    const char *AG, *LP; int G, c;
    __device__ __forceinline__ bool next(int i, Unit& u) const {
        const long L = (long)i * G + c; if (L >= 256) return false;
        const int j = 3 - (int)(L >> 6), pm = (int)(L & 63);
        u.pm = pm; u.pn = j; u.aux = 0; u.A = AG + (size_t)pm * (256 * AG_PITCH * 2); u.B = LP + (size_t)(pm >> 1) * (256 * LP_PITCH * 2) + (size_t)(48 - 16 * j) * 16 * 2;
        u.nt1 = 4 * (j + 1); u.nt = u.nt1 + 2; u.jumpA = (1024 - 256 * (j + 1)) * 2; u.jumpB = (1024 + 128 * j - ((48 - 16 * j) * 16 + 256 * (j + 1))) * 2; return true;
    }
};
}
namespace att {
__device__ __forceinline__ int crow(int r, int hi) { return (r & 3) + 8 * (r >> 2) + 4 * hi; }
__device__ __forceinline__ s16x4 vtr(const LAS char* p) { typedef short v4i16_t __attribute__((ext_vector_type(4))); return __builtin_bit_cast(s16x4, __builtin_amdgcn_ds_read_tr16_b64_v4i16((LAS v4i16_t*)p)); }

template <int D, int NKT, bool BAND>
__device__ __forceinline__ void attn_wave(const LAS char* Kl, const LAS char* Vl, int krow0, const bf16x8 (&qf)[D / 16], const LAS float* biasL, int valid_from,
                                          f32x16 (&o)[D / 32], float& m_out, float& l_out) {
    const int lane = threadIdx.x & 63, r = lane & 31, hh = lane >> 5;
    constexpr int RB = D * 2;
    float m = -INFINITY;
#pragma unroll 1
    for (int kt = 0; kt < NKT; ++kt) {
        const int krow = krow0 + 32 * kt + r; const LAS char* kp = Kl + krow * RB; const int sw = krow & 7;
        f32x16 s = {};
#pragma unroll
        for (int d0 = 0; d0 < D / 16; ++d0) { const bf16x8 kf = *(const LAS bf16x8*)(kp + (((2 * d0 + hh) ^ sw) << 4)); s = __builtin_amdgcn_mfma_f32_32x32x16_bf16(kf, qf[d0], s, 0, 0, 0); }
        float tm = -INFINITY;
#pragma unroll
        for (int rg = 0; rg < 16; ++rg) { float v = s[rg];
            if (BAND) { const int kl = crow(rg, hh), j = r + 128 - 32 * kt - kl; const bool ok = (j >= 0) && (j <= 128) && (krow0 + 32 * kt + kl >= valid_from); v = ok ? v + biasL[ok ? j : 0] : -INFINITY; }
            tm = fmaxf(tm, v); }
        m = fmaxf(m, tm);
    }
    m = fmaxf(m, __shfl_xor(m, 32));
    float l = 0.f;
#pragma unroll
    for (int db = 0; db < D / 32; ++db) o[db] = f32x16{};
    const int gi = lane >> 4, li = lane & 15;
    const int vcol = (16 * (gi & 1) + 4 * (li & 3)) * 2, vrow = 4 * (gi >> 1) + (li >> 2);
#pragma unroll 1
    for (int kt = 0; kt < NKT; ++kt) {
        const int krow = krow0 + 32 * kt + r; const LAS char* kp = Kl + krow * RB; const int sw = krow & 7;
        f32x16 s = {};
#pragma unroll
        for (int d0 = 0; d0 < D / 16; ++d0) { const bf16x8 kf = *(const LAS bf16x8*)(kp + (((2 * d0 + hh) ^ sw) << 4)); s = __builtin_amdgcn_mfma_f32_32x32x16_bf16(kf, qf[d0], s, 0, 0, 0); }
        float p[16]; float ps = 0.f;
#pragma unroll
        for (int rg = 0; rg < 16; ++rg) { float v = s[rg];
            if (BAND) { const int kl = crow(rg, hh), j = r + 128 - 32 * kt - kl; const bool ok = (j >= 0) && (j <= 128) && (krow0 + 32 * kt + kl >= valid_from); v = ok ? v + biasL[ok ? j : 0] : -INFINITY; }
            p[rg] = __builtin_amdgcn_exp2f(v - m); ps += p[rg]; }
        l += ps;
        u32x4 pw0, pw1;
        pw0.x = cvt_pk_bf16(p[0], p[1]); pw0.y = cvt_pk_bf16(p[2], p[3]); pw0.z = cvt_pk_bf16(p[4], p[5]); pw0.w = cvt_pk_bf16(p[6], p[7]);
        pw1.x = cvt_pk_bf16(p[8], p[9]); pw1.y = cvt_pk_bf16(p[10], p[11]); pw1.z = cvt_pk_bf16(p[12], p[13]); pw1.w = cvt_pk_bf16(p[14], p[15]);
        const bf16x8 pb0 = __builtin_bit_cast(bf16x8, pw0), pb1 = __builtin_bit_cast(bf16x8, pw1);
        const LAS char* vb = Vl + (krow0 + 32 * kt + vrow) * RB + vcol;
#pragma unroll
        for (int db = 0; db < D / 32; ++db) {
            const s16x4 a0 = vtr(vb + db * 64), a1 = vtr(vb + db * 64 + 8 * RB), a2 = vtr(vb + db * 64 + 16 * RB), a3 = vtr(vb + db * 64 + 24 * RB);
            const bf16x8 v0 = (bf16x8){a0[0], a0[1], a0[2], a0[3], a1[0], a1[1], a1[2], a1[3]}, v1 = (bf16x8){a2[0], a2[1], a2[2], a2[3], a3[0], a3[1], a3[2], a3[3]};
            o[db] = __builtin_amdgcn_mfma_f32_32x32x16_bf16(v0, pb0, o[db], 0, 0, 0);
            o[db] = __builtin_amdgcn_mfma_f32_32x32x16_bf16(v1, pb1, o[db], 0, 0, 0);
        }
    }
    l += __shfl_xor(l, 32);
    m_out = m; l_out = l;
}

template <int D> __device__ __forceinline__ void store_o(bf16_t* orow, const f32x16 (&o)[D / 32], float inv_l) {
    const int hh = (threadIdx.x & 63) >> 5;
#pragma unroll
    for (int db = 0; db < D / 32; ++db)
#pragma unroll
        for (int q4 = 0; q4 < 4; ++q4) { u32x2 w; w.x = cvt_pk_bf16(o[db][4 * q4] * inv_l, o[db][4 * q4 + 1] * inv_l); w.y = cvt_pk_bf16(o[db][4 * q4 + 2] * inv_l, o[db][4 * q4 + 3] * inv_l);
            *(u32x2*)(orow + 32 * db + 8 * q4 + 4 * hh) = w; }
}

__device__ const unsigned char BUCKETS[3][129] = {
{0,1,2,3,4,5,6,7,8,9,10,11,12,13,14,15,16,16,16,16,16,16,17,17,17,17,17,17,17,17,18,18,18,18,18,18,18,18,18,18,19,19,19,19,19,19,19,19,19,19,19,19,19,19,20,20,20,20,20,20,20,20,20,20,20,20,20,20,20,20,20,20,20,21,21,21,21,21,21,21,21,21,21,21,21,21,21,21,21,21,21,21,21,21,21,21,21,21,21,22,22,22,22,22,22,22,22,22,22,22,22,22,22,22,22,22,22,22,22,22,22,22,22,22,22,22,22,22,22},
{0,4,8,12,16,16,17,17,18,18,19,19,19,19,20,20,20,20,20,21,21,21,21,21,21,22,22,22,22,22,22,22,22,22,23,23,23,23,23,23,23,23,23,23,23,23,24,24,24,24,24,24,24,24,24,24,24,24,24,24,24,24,25,25,25,25,25,25,25,25,25,25,25,25,25,25,25,25,25,25,25,25,25,26,26,26,26,26,26,26,26,26,26,26,26,26,26,26,26,26,26,26,26,26,26,26,26,26,26,26,26,26,26,27,27,27,27,27,27,27,27,27,27,27,27,27,27,27,27},
{0,16,18,19,20,21,21,22,22,23,23,23,24,24,24,24,25,25,25,25,25,26,26,26,26,26,26,26,26,27,27,27,27,27,27,27,27,27,27,28,28,28,28,28,28,28,28,28,28,28,28,28,29,29,29,29,29,29,29,29,29,29,29,29,29,29,29,29,29,29,30,30,30,30,30,30,30,30,30,30,30,30,30,30,30,30,30,30,30,30,30,30,30,30,30,31,31,31,31,31,31,31,31,31,31,31,31,31,31,31,31,31,31,31,31,31,31,31,31,31,31,31,31,31,31,31,31,31,31}};

constexpr int LDS_K = 0, LDS_V = 65536, LDS_BIAS = 131072 + 4096;

__device__ __forceinline__ void dattn_unit(LAS unsigned char* lds, bf16_t* QKV, float* LSE, const float* rel, int b, int g, int h, int rs, int qt) {
    const int tid = threadIdx.x, lane = tid & 63, wid = __builtin_amdgcn_readfirstlane(tid >> 6), r = lane & 31, hh = lane >> 5;
    const int dil = (g == 0) ? 1 : (g == 1 ? 4 : 16);
    LAS char* Kl = (LAS char*)lds + LDS_K; LAS char* Vl = (LAS char*)lds + LDS_V; LAS float* biasL = (LAS float*)(lds + LDS_BIAS);
    const int nk0 = 256 * qt - 128;
    const size_t hcol = (size_t)g * 256 + h * 64;
#pragma unroll
    for (int i = 0; i < 6; ++i) { const int e = tid + 512 * i, row = e >> 3, ch = e & 7; const int nk = nk0 + row;
        u32x4 kv = {0u, 0u, 0u, 0u}, vv = {0u, 0u, 0u, 0u};
        if (nk >= 0) { const size_t tok = (size_t)b * SEQ + rs + (size_t)dil * nk; const bf16_t* src = QKV + tok * QKV_PITCH + hcol + ch * 8; kv = *(const u32x4*)(src + 768); vv = *(const u32x4*)(src + 1536); }
        *(LAS u32x4*)(Kl + row * 128 + ((ch ^ (row & 7)) << 4)) = kv; *(LAS u32x4*)(Vl + row * 128 + (ch << 4)) = vv; }
    if (tid < 129) biasL[tid] = rel[(int)BUCKETS[g][tid] * 12 + g * 4 + h] * LOG2E;
    const int nq = 256 * qt + 32 * wid + r; const size_t qtok = (size_t)b * SEQ + rs + (size_t)dil * nq; bf16_t* qrow = QKV + qtok * QKV_PITCH + hcol;
    bf16x8 qf[4];
#pragma unroll
    for (int s = 0; s < 4; ++s) qf[s] = *(const bf16x8*)(qrow + 16 * s + 8 * hh);
    __syncthreads();
    f32x16 o[2]; float m, l;
    attn_wave<64, 5, true>(Kl, Vl, 32 * wid, qf, biasL, (qt == 0) ? 128 : 0, o, m, l);
    store_o<64>(qrow, o, __builtin_amdgcn_rcpf(l));
    if (hh == 0) LSE[qtok * 12 + g * 4 + h] = m + __builtin_amdgcn_logf(l);
    __syncthreads();
}

__device__ __forceinline__ void xattn_unit(LAS unsigned char* lds, bf16_t* XQ, const bf16_t* MEMKV, int b, int hd, int qt) {
    const int tid = threadIdx.x, lane = tid & 63, wid = __builtin_amdgcn_readfirstlane(tid >> 6), r = lane & 31, hh = lane >> 5;
    LAS char* Kl = (LAS char*)lds + LDS_K; LAS char* Vl = (LAS char*)lds + LDS_V;
#pragma unroll
    for (int i = 0; i < 8; ++i) { const int e = tid + 512 * i, row = e >> 4, ch = e & 15; const bf16_t* src = MEMKV + (size_t)(b * MEM_LEN + row) * 1024 + hd * 128 + ch * 8;
        const u32x4 kv = *(const u32x4*)src, vv = *(const u32x4*)(src + 512);
        *(LAS u32x4*)(Kl + row * 256 + ((ch ^ (row & 7)) << 4)) = kv; *(LAS u32x4*)(Vl + row * 256 + (ch << 4)) = vv; }
    const size_t qtok = (size_t)b * SEQ + 256 * qt + 32 * wid + r; bf16_t* qrow = XQ + qtok * 512 + hd * 128;
    bf16x8 qf[8];
#pragma unroll
    for (int s = 0; s < 8; ++s) qf[s] = *(const bf16x8*)(qrow + 16 * s + 8 * hh);
    __syncthreads();
    f32x16 o[4]; float m, l;
    attn_wave<128, 8, false>(Kl, Vl, 0, qf, nullptr, 0, o, m, l);
    store_o<128>(qrow, o, __builtin_amdgcn_rcpf(l));
    __syncthreads();
}

__device__ __forceinline__ void combine_rows(bf16_t* QKV, const float* LSE, int gw, int ngw) {
    const int lane = threadIdx.x & 63; const int h = lane >> 4, c = (lane & 15) * 4;
    for (int tok = gw; tok < MTOK; tok += ngw) {
        const float l0 = LSE[(size_t)tok * 12 + h], l1 = LSE[(size_t)tok * 12 + 4 + h], l2 = LSE[(size_t)tok * 12 + 8 + h];
        const float mx = fmaxf(l0, fmaxf(l1, l2)); float w0 = __builtin_amdgcn_exp2f(l0 - mx), w1 = __builtin_amdgcn_exp2f(l1 - mx), w2 = __builtin_amdgcn_exp2f(l2 - mx);
        const float inv = __builtin_amdgcn_rcpf(w0 + w1 + w2); w0 *= inv; w1 *= inv; w2 *= inv;
        bf16_t* p = QKV + (size_t)tok * QKV_PITCH + h * 64 + c;
        const u32x2 a = *(const u32x2*)p, bq = *(const u32x2*)(p + 256), cq = *(const u32x2*)(p + 512);
        u32x2 w; w.x = cvt_pk_bf16(w0 * bf_lo(a.x) + w1 * bf_lo(bq.x) + w2 * bf_lo(cq.x), w0 * bf_hi(a.x) + w1 * bf_hi(bq.x) + w2 * bf_hi(cq.x));
        w.y = cvt_pk_bf16(w0 * bf_lo(a.y) + w1 * bf_lo(bq.y) + w2 * bf_lo(cq.y), w0 * bf_hi(a.y) + w1 * bf_hi(bq.y) + w2 * bf_hi(cq.y));
        *(u32x2*)p = w;
    }
}
}
namespace ssm {
constexpr int L_WP = 0, L_BB = L_WP + 65 * 64 * 2 * 4, L_CC = L_BB + 64 * 16 * 2 * 4, L_KT = L_CC + 16 * 64 * 2 * 4;
static_assert(L_KT + 64 * 256 * 4 <= 131072, "ssm lds");

__device__ __forceinline__ void build_group(LAS unsigned char* lds, int g, const float* a_re, const float* a_im, const float* log_dt, const float* b_re, const float* b_im,
                                            const float* c_re, const float* c_im, const float* dsk, bf16_t* LP, bf16_t* QT) {
    const int tid = threadIdx.x;
    LAS float* WP = (LAS float*)(lds + L_WP); LAS float* BB = (LAS float*)(lds + L_BB); LAS float* CC = (LAS float*)(lds + L_CC); LAS float* KT = (LAS float*)(lds + L_KT);
    const double dt = exp((double)log_dt[g]);
    for (int e = tid; e < 65 * 64; e += 512) { const int tau = e >> 6, p = e & 63; const double ar = a_re[g * 64 + p], ai = a_im[g * 64 + p];
        const double mag = exp(ar * dt * tau), ang = ai * dt * tau; WP[2 * (p * 65 + tau)] = (float)(mag * cos(ang)); WP[2 * (p * 65 + tau) + 1] = (float)(mag * sin(ang)); }
    for (int e = tid; e < 1024; e += 512) { const int p = e >> 4, h = e & 15; const double ar = a_re[g * 64 + p], ai = a_im[g * 64 + p];
        const double mag = exp(ar * dt), ang = ai * dt, abr = mag * cos(ang), abi = mag * sin(ang), nr = abr - 1.0, ni = abi, den = ar * ar + ai * ai;
        const double cr = (nr * ar + ni * ai) / den, ci = (ni * ar - nr * ai) / den; const double br = b_re[(g * 64 + p) * 16 + h], bi = b_im[(g * 64 + p) * 16 + h];
        BB[2 * e] = (float)(cr * br - ci * bi); BB[2 * e + 1] = (float)(cr * bi + ci * br);
        CC[2 * e] = c_re[(g * 16 + h) * 64 + p]; CC[2 * e + 1] = c_im[(g * 16 + h) * 64 + p]; }
    __syncthreads();
    for (int e = tid; e < 64 * 16; e += 512) { const int tau = e >> 4, h = e & 15; float s[16];
#pragma unroll
        for (int hp = 0; hp < 16; ++hp) s[hp] = 0.f;
        for (int p = 0; p < 64; ++p) { const f32x2 c = *(const LAS f32x2*)(CC + 2 * (p * 16 + h)), w = *(const LAS f32x2*)(WP + 2 * (p * 65 + tau));
            const float cwr = c.x * w.x - c.y * w.y, cwi = c.x * w.y + c.y * w.x;
#pragma unroll
            for (int hp = 0; hp < 16; ++hp) { const f32x2 bb = *(const LAS f32x2*)(BB + 2 * (p * 16 + hp)); s[hp] += cwr * bb.x - cwi * bb.y; } }
#pragma unroll
        for (int hp = 0; hp < 16; ++hp) KT[tau * 256 + h * 16 + hp] = s[hp] + ((tau == 0 && h == hp) ? dsk[g * 16 + h] : 0.f); }
    __syncthreads();
    bf16_t* lp = LP + (size_t)g * 256 * LP_PITCH;
    for (int e = tid; e < 256 * 128; e += 512) { const int n = e >> 7, c8 = e & 127, tl = n >> 4, h = n & 15, si = c8 >> 1, hp0 = (c8 & 1) * 8; const int tau = tl + 48 - si;
        u32x4 w = {0u, 0u, 0u, 0u};
        if (tau >= 0 && tau <= 63) { const LAS float* k = KT + tau * 256 + h * 16 + hp0; w.x = cvt_pk_bf16(k[0], k[1]); w.y = cvt_pk_bf16(k[2], k[3]); w.z = cvt_pk_bf16(k[4], k[5]); w.w = cvt_pk_bf16(k[6], k[7]); }
        *(u32x4*)(lp + (size_t)n * LP_PITCH + c8 * 8) = w; }
    for (int e = tid; e < 256 * 64; e += 512) { const int n = e >> 6, q = e & 63, j = q >> 4, p0 = (q & 15) * 4, tl = n >> 4, h = n & 15, tau = 16 * j + tl + 1; float v[8];
#pragma unroll
        for (int i = 0; i < 4; ++i) { const int p = p0 + i; const float cr = CC[2 * (p * 16 + h)], ci = CC[2 * (p * 16 + h) + 1], wr = WP[2 * (p * 65 + tau)], wi = WP[2 * (p * 65 + tau) + 1];
            v[2 * i] = cr * wr - ci * wi; v[2 * i + 1] = -(cr * wi + ci * wr); }
        u32x4 w; w.x = cvt_pk_bf16(v[0], v[1]); w.y = cvt_pk_bf16(v[2], v[3]); w.z = cvt_pk_bf16(v[4], v[5]); w.w = cvt_pk_bf16(v[6], v[7]);
        *(u32x4*)(lp + (size_t)n * LP_PITCH + 1024 + 128 * j + 2 * p0) = w; }
    bf16_t* qt = QT + (size_t)g * 128 * 1024;
    for (int e = tid; e < 128 * 128; e += 512) { const int rw = e >> 7, c8 = e & 127, p = rw >> 1, ri = rw & 1, s = c8 >> 1, hp0 = (c8 & 1) * 8; const int tau = 63 - s;
        const float wr = WP[2 * (p * 65 + tau)], wi = WP[2 * (p * 65 + tau) + 1]; float v[8];
#pragma unroll
        for (int i = 0; i < 8; ++i) { const float br = BB[2 * (p * 16 + hp0 + i)], bi = BB[2 * (p * 16 + hp0 + i) + 1]; v[i] = ri ? (wr * bi + wi * br) : (wr * br - wi * bi); }
        u32x4 w; w.x = cvt_pk_bf16(v[0], v[1]); w.y = cvt_pk_bf16(v[2], v[3]); w.z = cvt_pk_bf16(v[4], v[5]); w.w = cvt_pk_bf16(v[6], v[7]);
        *(u32x4*)(qt + (size_t)rw * 1024 + c8 * 8) = w; }
    __syncthreads();
}

__device__ __forceinline__ void carry_scan(int gthread, const float* a_re, const float* a_im, const float* log_dt, const float* SLOC, bf16_t* AG) {
    if (gthread >= 32 * 4 * 64) return;
    const int p = gthread & 63, b = (gthread >> 6) & 3, g = gthread >> 8;
    const double dt = exp((double)log_dt[g]); const double ar = a_re[g * 64 + p], ai = a_im[g * 64 + p]; const double mag = exp(ar * dt * 64.0), ang = ai * dt * 64.0;
    const float wr = (float)(mag * cos(ang)), wi = (float)(mag * sin(ang));
    float xr = 0.f, xi = 0.f;
    const f32x2* sl = (const f32x2*)(SLOC + ((size_t)g * 512 + b * 128) * 128) + p; unsigned* xo = (unsigned*)(AG + ((size_t)g * 512 + b * 128) * AG_PITCH + 1024) + p;
    for (int c0 = 0; c0 < 128; c0 += 8) {
        f32x2 s[8];
#pragma unroll
        for (int i = 0; i < 8; ++i) s[i] = sl[(size_t)(c0 + i) * 64];
#pragma unroll
        for (int i = 0; i < 8; ++i) { xo[(size_t)(c0 + i) * (AG_PITCH / 2)] = cvt_pk_bf16(xr, xi); const float nr = wr * xr - wi * xi + s[i].x, ni = wr * xi + wi * xr + s[i].y; xr = nr; xi = ni; }
    }
}
}

namespace prep {
__device__ __forceinline__ void transpose_item(const float* W, int K, int N, bf16_t* WT, int half, const float* gain, LAS float* scr, int item, int lane) {
    const int nblk = N / 32, kb = item / nblk, nb = item % nblk, k0 = 64 * kb, n0 = 32 * nb;
#pragma unroll 8
    for (int i = 0; i < 32; ++i) { const int kk = 2 * i + (lane >> 5); float v = W[(size_t)(k0 + kk) * N + n0 + (lane & 31)]; if (gain) v *= gain[k0 + kk]; scr[kk * 33 + (lane & 31)] = v; }
    asm volatile("s_waitcnt lgkmcnt(0)" ::: "memory");
    const int c = lane & 7;
#pragma unroll
    for (int j = 0; j < 4; ++j) { const int nl = (lane >> 3) + 8 * j; const LAS float* s = scr + (8 * c) * 33 + nl; int n = n0 + nl, row = n;
        if (half > 0) { const int isb = n >= half; const int cc = isb ? n - half : n; row = (cc >> 7) * 256 + (isb ? 128 : 0) + (cc & 127); }
        u32x4 o; o.x = cvt_pk_bf16(s[0 * 33], s[1 * 33]); o.y = cvt_pk_bf16(s[2 * 33], s[3 * 33]); o.z = cvt_pk_bf16(s[4 * 33], s[5 * 33]); o.w = cvt_pk_bf16(s[6 * 33], s[7 * 33]);
        *(u32x4*)(WT + (size_t)row * K + k0 + 8 * c) = o; }
    asm volatile("s_waitcnt lgkmcnt(0)" ::: "memory");
}
__device__ __forceinline__ void row_to_bf16(const float* xrow, bf16_t* orow, float* ss, int lane) {
    const f32x4* xr = (const f32x4*)xrow + lane; f32x4 v[4]; float s = 0.f;
#pragma unroll
    for (int j = 0; j < 4; ++j) { v[j] = xr[64 * j]; s += (v[j][0] * v[j][0] + v[j][1] * v[j][1]) + (v[j][2] * v[j][2] + v[j][3] * v[j][3]); }
    s = wave_sum(s);
    u32x2* o8 = (u32x2*)orow + lane;
#pragma unroll
    for (int j = 0; j < 4; ++j) { u32x2 w; w.x = cvt_pk_bf16(v[j][0], v[j][1]); w.y = cvt_pk_bf16(v[j][2], v[j][3]); o8[64 * j] = w; }
    if (lane == 0) *ss = s;
}
__device__ __forceinline__ void final_row(float* xrow, const float* ss4, int row, const float* gain, int lane) {
    const float r = rsqrtf(((ss4[row] + ss4[MTOK + row]) + (ss4[2 * MTOK + row] + ss4[3 * MTOK + row])) * (1.f / D_MODEL) + EPS);
    f32x4* xr = (f32x4*)xrow + lane; const f32x4* gr = (const f32x4*)gain + lane;
#pragma unroll
    for (int j = 0; j < 4; ++j) { const f32x4 v = xr[64 * j], g = gr[64 * j]; xr[64 * j] = v * r * g; }
}
}
#define RLX_AGENT __ATOMIC_RELAXED, __HIP_MEMORY_SCOPE_AGENT
#define XB_TMO      128
#define XB_XCNT(j)  (256  + 64 * (j))
#define XB_XSUB(j)  (1280 + 64 * (j))
#define XB_XGEN(j)  (2304 + 64 * (j))
#define XB_TOP      3328
#define XB_TOPGEN   3392
#define XCD_BAR_WORDS 3456
#define XB_SPIN_CAP (1u << 22)
__device__ __forceinline__ unsigned xb_ld(unsigned* p)              { return __hip_atomic_load(p, __ATOMIC_RELAXED, __HIP_MEMORY_SCOPE_AGENT); }
__device__ __forceinline__ unsigned xb_add(unsigned* p, unsigned v) { return __hip_atomic_fetch_add(p, v, __ATOMIC_RELAXED, __HIP_MEMORY_SCOPE_AGENT); }
__device__ __forceinline__ unsigned xb_xcc_id() { return (unsigned)__builtin_amdgcn_s_getreg((3 << 11) | 20) & 0xFu; }
#define XB_SPIN(cond, bar) do { unsigned _sp = 0; while (cond) { __builtin_amdgcn_s_sleep(1); \
    if ((++_sp & 255u) == 0u) { if (xb_ld(&(bar)[XB_TMO])) break; if (_sp > XB_SPIN_CAP) { atomicAdd(&(bar)[XB_TMO], 1u); break; } } } } while (0)
struct XcdBarrier { unsigned* bar; unsigned x; volatile LAS unsigned* st; };
__device__ __forceinline__ XcdBarrier xcd_barrier_post(unsigned* bar, volatile LAS unsigned* st) {
    XcdBarrier b; b.bar = bar; b.x = xb_xcc_id(); b.st = st;
    if (threadIdx.x == 0) (void)xb_add(&bar[XB_XCNT(b.x)], 1u);
    return b;
}
__device__ __forceinline__ void xcd_barrier_complete(unsigned* bar, unsigned x, unsigned& nloc, unsigned& nx) {
    const unsigned G = gridDim.x * gridDim.y * gridDim.z;
    unsigned sum, cnt, mine, sp = 0u;
    for (;;) {
        sum = 0u; cnt = 0u; mine = 0u;
#pragma unroll
        for (unsigned j = 0; j < 16; ++j) { const unsigned c = xb_ld(&bar[XB_XCNT(j)]); sum += c; cnt += (c > 0u) ? 1u : 0u; mine = (j == x) ? c : mine; }
        if (sum == G) break;
        __builtin_amdgcn_s_sleep(1);
        if ((++sp & 255u) == 0u) { if (xb_ld(&bar[XB_TMO])) break; if (sp > XB_SPIN_CAP) { atomicAdd(&bar[XB_TMO], 1u); break; } }
    }
    nloc = mine > 0u ? mine : 1u; nx = cnt > 0u ? cnt : 1u;
}
__device__ __forceinline__ void xcd_barrier(const XcdBarrier& b) {
    asm volatile("s_waitcnt vmcnt(0)" ::: "memory");
    __syncthreads();
    if (threadIdx.x == 0) {
        unsigned* bar = b.bar;
        __builtin_amdgcn_s_waitcnt(0);
        unsigned nloc = b.st[0], nx = b.st[1];
        if (nloc == 0u) { xcd_barrier_complete(bar, b.x, nloc, nx); b.st[0] = nloc; b.st[1] = nx; }
        const unsigned old = xb_add(&bar[XB_XSUB(b.x)], 1u);
        const unsigned gen = old / nloc;
        if (old + 1u == (gen + 1u) * nloc) {
            __builtin_amdgcn_fence(__ATOMIC_RELEASE, "agent");
            asm volatile("s_waitcnt vmcnt(0)" ::: "memory");
            const unsigned og = xb_add(&bar[XB_TOP], 1u);
            const unsigned tg = og / nx;
            if (og + 1u == (tg + 1u) * nx) xb_add(&bar[XB_TOPGEN], 1u);
            else XB_SPIN(xb_ld(&bar[XB_TOPGEN]) == tg, bar);
            __builtin_amdgcn_fence(__ATOMIC_ACQUIRE, "agent");
            xb_add(&bar[XB_XGEN(b.x)], 1u);
            asm volatile("s_waitcnt vmcnt(0)" ::: "memory");
        } else {
            XB_SPIN(xb_ld(&bar[XB_XGEN(b.x)]) == gen, bar);
            __builtin_amdgcn_fence(__ATOMIC_ACQUIRE, "agent");
            asm volatile("s_waitcnt vmcnt(0)" ::: "memory");
        }
    }
    __syncthreads();
}

constexpr int LDS_STAGE = 0;
constexpr int LDS_EPI = 131072;
constexpr int LDS_BIASTAB = 131072 + 4096;
constexpr int LDS_MISC = 131072 + 4096 + 1024;
constexpr int LDS_BYTES = 147456;
constexpr int NPHASE = 15;

struct Args { const float* in[26]; float* out; unsigned char* ws; int ph_lo, ph_hi; };

__global__ void __launch_bounds__(512, 2) mega_fwd(Args args) {
    extern __shared__ __attribute__((aligned(16))) unsigned char lds_raw[];
    LAS unsigned char* lds = (LAS unsigned char*)lds_raw;
    const int tid = threadIdx.x, lane = tid & 63, wave = __builtin_amdgcn_readfirstlane(tid >> 6);
    const int G = gridDim.x, c = blockIdx.x;
    const int gw = c * 8 + wave, NGW = G * 8;
    unsigned char* ws = args.ws;
    const float* const* in = args.in;
    volatile LAS unsigned* MISC = (volatile LAS unsigned*)(lds + LDS_MISC);
    if (tid < 64) MISC[tid] = 0u;
    __syncthreads();
    const int lo = args.ph_lo, hi = args.ph_hi;
    const bool multi = (hi - lo) > 1;
    XcdBarrier bar; bar.bar = (unsigned*)(ws + WS_CTL); bar.x = 0; bar.st = nullptr;
    if (multi) bar = xcd_barrier_post((unsigned*)(ws + WS_CTL), MISC);
#define IN(k) (lo <= (k) && (k) < hi)
#define SEAM(k) do { if (IN(k) && IN((k) + 1)) xcd_barrier(bar); } while (0)

    float* OUT = args.out;
    float* SS1 = (float*)(ws + WS_SS1); float* SS2 = (float*)(ws + WS_SS2); float* SS3 = (float*)(ws + WS_SS3); float* SS4 = (float*)(ws + WS_SS4); float* SSMEM = (float*)(ws + WS_SSM);
    bf16_t* MEMB = (bf16_t*)(ws + WS_MEMB); bf16_t* MEMKV = (bf16_t*)(ws + WS_MEMKV);
    bf16_t* WIN = (bf16_t*)(ws + WS_WIN); bf16_t* WGLU = (bf16_t*)(ws + WS_WGLU); bf16_t* WAU = (bf16_t*)(ws + WS_WAU); bf16_t* WKV = (bf16_t*)(ws + WS_WKV);
    bf16_t* WMU = (bf16_t*)(ws + WS_WMU); bf16_t* WOUT = (bf16_t*)(ws + WS_WOUT); bf16_t* WFIN = (bf16_t*)(ws + WS_WFIN); bf16_t* WFDN = (bf16_t*)(ws + WS_WFDN);
    bf16_t* XB = (bf16_t*)(ws + WS_XB); bf16_t* LP = (bf16_t*)(ws + WS_LP); bf16_t* QT = (bf16_t*)(ws + WS_QT); float* SLOC = (float*)(ws + WS_SLOC); float* LSE = (float*)(ws + WS_LSE);
    bf16_t* HB = (bf16_t*)(ws + WS_H); bf16_t* QKV = (bf16_t*)(ws + WS_QKV); bf16_t* XQ = (bf16_t*)(ws + WS_XQ); bf16_t* AG = (bf16_t*)(ws + WS_AG); bf16_t* GATE = (bf16_t*)(ws + WS_GATE);
    bf16_t* GATE_S = GATE; bf16_t* MERGED = GATE + (size_t)MTOK * D_MODEL; bf16_t* GATE_M = GATE + 2 * (size_t)MTOK * D_MODEL;
    LAS float* scr = (LAS float*)(lds + LDS_STAGE + wave * 16384);

    if (IN(0)) {
        constexpr int I_FIN = 16 * 176, I_FDN = 44 * 32, I_WIN = 16 * 200, I_GLU = 8 * 64, I_AU = 4 * 32, I_KV = 16 * 32, I_MU = 8 * 32, I_OUT = 16 * 32;
        constexpr int NIT = I_FIN + I_FDN + I_WIN + I_GLU + I_AU + I_KV + I_MU + I_OUT;
        for (int it = gw; it < NIT; it += NGW) { int r = it;
            if (r < I_FIN) { prep::transpose_item(in[3], 1024, 5632, WFIN, 2816, in[2], scr, r, lane); continue; } r -= I_FIN;
            if (r < I_FDN) { prep::transpose_item(in[4], 2816, 1024, WFDN, 0, nullptr, scr, r, lane); continue; } r -= I_FDN;
            if (r < I_WIN) { prep::transpose_item(in[6], 1024, 6400, WIN, 0, in[5], scr, r, lane); continue; } r -= I_WIN;
            if (r < I_GLU) { prep::transpose_item(in[15], 512, 2048, WGLU, 1024, nullptr, scr, r, lane); continue; } r -= I_GLU;
            if (r < I_AU) { prep::transpose_item(in[17], 256, 1024, WAU, 0, nullptr, scr, r, lane); continue; } r -= I_AU;
            if (r < I_KV) { prep::transpose_item(in[19], 1024, 1024, WKV, 0, in[18], scr, r, lane); continue; } r -= I_KV;
            if (r < I_MU) { prep::transpose_item(in[20], 512, 1024, WMU, 0, nullptr, scr, r, lane); continue; } r -= I_MU;
            prep::transpose_item(in[21], 1024, 1024, WOUT, 0, nullptr, scr, r, lane);
        }
        for (int m = gw; m < MTOK; m += NGW) prep::row_to_bf16(in[0] + (size_t)m * D_MODEL, XB + (size_t)m * D_MODEL, SS1 + m, lane);
        for (int m = gw; m < MEMROWS; m += NGW) prep::row_to_bf16(in[1] + (size_t)m * D_MODEL, MEMB + (size_t)m * D_MODEL, SSMEM + m, lane);
    }
    SEAM(0);
    if (IN(1)) {
        g8::OrdDense S{(const char*)XB, (const char*)WFIN, 128, 22, 16, G, c, (size_t)256 * 1024 * 2, (size_t)256 * 1024 * 2};
        g8::EpiSwiglu E{HB, SS1, 1};
        g8::gemm_phase<g8::EpiSwiglu, g8::OrdDense, false>(lds, g8::Cfg{1024, 1024, (size_t)128 * 1024 * 2, (size_t)128 * 1024 * 2}, S, E);
    }
    SEAM(1);
    if (IN(2)) {
        g8::OrdDense S{(const char*)HB, (const char*)WFDN, 128, 4, 44, G, c, (size_t)256 * D_FF * 2, (size_t)256 * D_FF * 2};
        g8::EpiResid E{in[0], OUT, XB, SS2, 0.5f};
        g8::gemm_phase<g8::EpiResid, g8::OrdDense, false>(lds, g8::Cfg{D_FF, D_FF, (size_t)128 * D_FF * 2, (size_t)128 * D_FF * 2}, S, E);
    }
    SEAM(2);
    if (IN(3)) {
        g8::OrdProj S{(const char*)XB, (const char*)WIN, (const char*)MEMB, (const char*)WKV, G, c};
        g8::EpiProj E{SS2, SSMEM, AG, QKV, XQ, GATE, MEMKV};
        g8::gemm_phase<g8::EpiProj, g8::OrdProj, false>(lds, g8::Cfg{1024, 1024, (size_t)128 * 1024 * 2, (size_t)128 * 1024 * 2}, S, E);
    }
    SEAM(3);
    if (IN(4)) {
        if (c < 32) ssm::build_group(lds, c, in[7], in[8], in[9], in[10], in[11], in[12], in[13], in[14], LP, QT);
        for (int u = c; u < 1536; u += G) { const int x = u & 31, h = (u >> 5) & 3, rest = u >> 7, g = rest % 3, b = rest / 3; const int ntile = (g == 0) ? 32 : (g == 1 ? 8 : 2);
            att::dattn_unit(lds, QKV, LSE, in[16], b, g, h, x / ntile, x % ntile); }
        for (int u = c; u < 512; u += G) { const int qt = u & 31, hd = (u >> 5) & 3, b = u >> 7; att::xattn_unit(lds, XQ, MEMKV, b, hd, qt); }
    }
    SEAM(4);
    if (IN(5)) {
        { g8::OrdSloc S{(const char*)AG, (const char*)QT, G, c}; g8::EpiSloc E{SLOC};
          g8::gemm_phase<g8::EpiSloc, g8::OrdSloc, false>(lds, g8::Cfg{AG_PITCH, 1024, (size_t)128 * AG_PITCH * 2, 0}, S, E); }
        att::combine_rows(QKV, LSE, gw, NGW);
        constexpr int I_FIN = 16 * 176, I_FDN = 44 * 32;
        for (int it = gw; it < I_FIN + I_FDN; it += NGW) {
            if (it < I_FIN) prep::transpose_item(in[23], 1024, 5632, WFIN, 2816, in[22], scr, it, lane);
            else prep::transpose_item(in[24], 2816, 1024, WFDN, 0, nullptr, scr, it - I_FIN, lane); }
    }
    SEAM(5);
    if (IN(6)) { if (c < 16) ssm::carry_scan(c * 512 + tid, in[7], in[8], in[9], SLOC, AG); }
    SEAM(6);
    if (IN(7)) {
        g8::OrdY S{(const char*)AG, (const char*)LP, G, c}; g8::EpiY E{QKV + 768};
        g8::gemm_phase<g8::EpiY, g8::OrdY, true>(lds, g8::Cfg{AG_PITCH, LP_PITCH, (size_t)128 * AG_PITCH * 2, (size_t)128 * LP_PITCH * 2}, S, E);
    }
    SEAM(7);
    if (IN(8)) {
        g8::OrdDense S{(const char*)QKV, (const char*)WAU, 128, 4, 4, G, c, (size_t)256 * QKV_PITCH * 2, (size_t)256 * 256 * 2}; g8::EpiMerge<0> E{MERGED, MERGED};
        g8::gemm_phase<g8::EpiMerge<0>, g8::OrdDense, false>(lds, g8::Cfg{QKV_PITCH, 256, (size_t)128 * QKV_PITCH * 2, (size_t)128 * 256 * 2}, S, E);
    }
    SEAM(8);
    if (IN(9)) {
        g8::OrdDense S{(const char*)XQ, (const char*)WMU, 128, 4, 8, G, c, (size_t)256 * 512 * 2, (size_t)256 * 512 * 2}; g8::EpiMerge<1> E{GATE_M, MERGED};
        g8::gemm_phase<g8::EpiMerge<1>, g8::OrdDense, false>(lds, g8::Cfg{512, 512, (size_t)128 * 512 * 2, (size_t)128 * 512 * 2}, S, E);
    }
    SEAM(9);
    if (IN(10)) {
        g8::OrdDense S{(const char*)(QKV + 768), (const char*)WGLU, 128, 8, 8, G, c, (size_t)256 * QKV_PITCH * 2, (size_t)256 * 512 * 2}; g8::EpiMerge<2> E{GATE_S, MERGED};
        g8::gemm_phase<g8::EpiMerge<2>, g8::OrdDense, false>(lds, g8::Cfg{QKV_PITCH, 512, (size_t)128 * QKV_PITCH * 2, (size_t)128 * 512 * 2}, S, E);
    }
    SEAM(10);
    if (IN(11)) {
        g8::OrdDense S{(const char*)MERGED, (const char*)WOUT, 128, 4, 16, G, c, (size_t)256 * 1024 * 2, (size_t)256 * 1024 * 2}; g8::EpiResid E{OUT, OUT, XB, SS3, 1.0f};
        g8::gemm_phase<g8::EpiResid, g8::OrdDense, false>(lds, g8::Cfg{1024, 1024, (size_t)128 * 1024 * 2, (size_t)128 * 1024 * 2}, S, E);
    }
    SEAM(11);
    if (IN(12)) {
        g8::OrdDense S{(const char*)XB, (const char*)WFIN, 128, 22, 16, G, c, (size_t)256 * 1024 * 2, (size_t)256 * 1024 * 2}; g8::EpiSwiglu E{HB, SS3, 4};
        g8::gemm_phase<g8::EpiSwiglu, g8::OrdDense, false>(lds, g8::Cfg{1024, 1024, (size_t)128 * 1024 * 2, (size_t)128 * 1024 * 2}, S, E);
    }
    SEAM(12);
    if (IN(13)) {
        g8::OrdDense S{(const char*)HB, (const char*)WFDN, 128, 4, 44, G, c, (size_t)256 * D_FF * 2, (size_t)256 * D_FF * 2}; g8::EpiResid E{OUT, OUT, XB, SS4, 0.5f};
        g8::gemm_phase<g8::EpiResid, g8::OrdDense, false>(lds, g8::Cfg{D_FF, D_FF, (size_t)128 * D_FF * 2, (size_t)128 * D_FF * 2}, S, E);
    }
    SEAM(13);
    if (IN(14)) { for (int m = gw; m < MTOK; m += NGW) prep::final_row(OUT + (size_t)m * D_MODEL, SS4, m, in[25], lane); }
#undef IN
#undef SEAM
}

#ifndef MK_MULTI
#define MK_MULTI 1
#endif
extern "C" void kernel_launch(void* const* d_in, const int* in_sizes, int n_in, void* d_out, int out_size, void* d_ws, size_t ws_size, hipStream_t stream) {
    static int ready = 0;
    if (!ready) {
        if (n_in != 26 || in_sizes[0] != MTOK * D_MODEL || out_size != MTOK * D_MODEL || ws_size < WS_END) { fprintf(stderr, "kernel_launch: unexpected problem: n_in %d, in0 %d, out %d, ws %zu (need %zu)\n", n_in, n_in > 0 ? in_sizes[0] : -1, out_size, ws_size, (size_t)WS_END); ready = -1; return; }
        if (hipFuncSetAttribute((const void*)mega_fwd, hipFuncAttributeMaxDynamicSharedMemorySize, LDS_BYTES) != hipSuccess) { fprintf(stderr, "kernel_launch: hipFuncSetAttribute failed\n"); ready = -1; return; }
        ready = 1;
    }
    if (ready < 0) return;
    (void)hipMemsetAsync((char*)d_ws + WS_CTL, 0, 64 * 1024, stream);
    Args a{};
    for (int i = 0; i < 26; ++i) a.in[i] = (const float*)d_in[i];
    a.out = (float*)d_out; a.ws = (unsigned char*)d_ws;
#if MK_MULTI
    for (int p = 0; p < NPHASE; ++p) { a.ph_lo = p; a.ph_hi = p + 1; hipLaunchKernelGGL(mega_fwd, dim3(256), dim3(512), LDS_BYTES, stream, a); }
#else
    a.ph_lo = 0; a.ph_hi = NPHASE;
    hipLaunchKernelGGL(mega_fwd, dim3(256), dim3(512), LDS_BYTES, stream, a);
#endif
}
```

```cpp
#include <hip/hip_runtime.h>
#include <cstdio>
#include <cstdint>
#include <cmath>
#define MK_MULTI 0
#define LAS __attribute__((address_space(3)))
#define GAS __attribute__((address_space(1)))
typedef unsigned short bf16_t;
typedef short bf16x8 __attribute__((ext_vector_type(8)));
typedef short s16x4 __attribute__((ext_vector_type(4)));
typedef float f32x4 __attribute__((ext_vector_type(4)));
typedef float f32x2 __attribute__((ext_vector_type(2)));
typedef float f32x16 __attribute__((ext_vector_type(16)));
typedef unsigned u32x4 __attribute__((ext_vector_type(4)));
typedef unsigned u32x2 __attribute__((ext_vector_type(2)));

constexpr int D_MODEL = 1024, NBATCH = 4, SEQ = 8192, MTOK = NBATCH * SEQ;
constexpr int D_FF = 2816, IN_WIDTH = 6400, MEM_LEN = 256, MEMROWS = NBATCH * MEM_LEN;
constexpr float EPS = 1e-6f;
constexpr float LOG2E = 1.4426950408889634f;

__device__ __forceinline__ unsigned cvt_pk_bf16(float lo, float hi) { unsigned r; asm volatile("v_cvt_pk_bf16_f32 %0, %1, %2" : "=v"(r) : "v"(lo), "v"(hi)); return r; }
__device__ __forceinline__ float bf_lo(unsigned w) { return __uint_as_float(w << 16); }
__device__ __forceinline__ float bf_hi(unsigned w) { return __uint_as_float(w & 0xffff0000u); }
__device__ __forceinline__ float fast_sigmoid(float v) { return __builtin_amdgcn_rcpf(1.f + __builtin_amdgcn_exp2f(-v * LOG2E)); }
__device__ __forceinline__ float gelu_tanh_f(float v) { const float z = 0.7978845608028654f * (v + 0.044715f * v * v * v); return v * __builtin_amdgcn_rcpf(1.f + __builtin_amdgcn_exp2f(-2.f * LOG2E * z)); }
__device__ __forceinline__ float wave_sum(float v) {
#pragma unroll
    for (int o = 1; o < 64; o <<= 1) v += __shfl_xor(v, o);
    return v;
}

constexpr size_t KiB = 1024;
constexpr size_t WS_CTL = 0;
constexpr size_t WS_SS1 = 64 * KiB;
constexpr size_t WS_SS2 = WS_SS1 + 128 * KiB;
constexpr size_t WS_SS3 = WS_SS2 + 512 * KiB;
constexpr size_t WS_SS4 = WS_SS3 + 512 * KiB;
constexpr size_t WS_SSM = WS_SS4 + 512 * KiB;
constexpr size_t WS_MEMB = 1792 * KiB;
constexpr size_t WS_MEMKV = WS_MEMB + 2048 * KiB;
constexpr size_t WS_WIN = WS_MEMKV + 2048 * KiB;
constexpr size_t WS_WGLU = WS_WIN + 12800 * KiB;
constexpr size_t WS_WAU = WS_WGLU + 2048 * KiB;
constexpr size_t WS_WKV = WS_WAU + 512 * KiB;
constexpr size_t WS_WMU = WS_WKV + 2048 * KiB;
constexpr size_t WS_WOUT = WS_WMU + 1024 * KiB;
constexpr size_t WS_WFIN = WS_WOUT + 2048 * KiB;
constexpr size_t WS_WFDN = WS_WFIN + 11264 * KiB;
constexpr size_t WS_XB = WS_WFDN + 5632 * KiB;
constexpr size_t WS_LP = WS_XB;
constexpr size_t WS_QT = WS_LP + 24576 * KiB;
constexpr size_t WS_SLOC = WS_QT + 8192 * KiB;
constexpr size_t WS_LSE = WS_SLOC + 8192 * KiB;
constexpr size_t WS_BIG = WS_XB + 65536 * KiB;
constexpr size_t WS_H = WS_BIG;
constexpr size_t WS_QKV = WS_BIG;
constexpr size_t WS_XQ = WS_QKV + 147456 * KiB;
constexpr size_t WS_AG = WS_XQ + 32768 * KiB;
constexpr size_t WS_GATE = WS_AG + 36864 * KiB;
constexpr size_t WS_END = WS_GATE + 3 * 65536 * KiB;
static_assert(WS_SSM + 4 * KiB <= WS_MEMB, "ws map");
static_assert(WS_LSE + 1536 * KiB <= WS_BIG, "ws map");
static_assert(WS_END <= (size_t)512 * 1024 * KiB, "ws map exceeds 512 MiB");
constexpr int QKV_PITCH = 2304, AG_PITCH = 1152, LP_PITCH = 1536;
namespace g8 {
constexpr int BM = 256, BK = 64, HALF = 128, HTB = HALF * BK * 2, STAGE_BYTES = 8 * HTB;

__host__ __device__ __forceinline__ int lds_byte(int r, int c) { const int st = (r >> 4) * 2 + (c >> 5), rr = r & 15, cc = c & 31, ob = rr * 64 + cc * 2; return st * 1024 + (ob ^ (((ob >> 9) & 1) << 5)); }
__host__ __device__ __forceinline__ void stage_rc(int b, int& R, int& C) { const int st = b / 1024, sb = b % 1024, swz = sb ^ (((sb >> 9) & 1) << 5); R = (st >> 1) * 16 + swz / 64; C = (st & 1) * 32 + (swz % 64) / 2; }
__host__ __device__ __forceinline__ int perm32(int rho) { const int n = rho >> 4, i = rho & 15; return 8 * (i >> 2) + 4 * n + (i & 3); }

struct Unit { const char* A; const char* B; int pm, pn, aux, nt, nt1, jumpA, jumpB; };
struct Cfg { int lda, ldb; size_t hstepA, hstepB; };

__device__ __forceinline__ void decode_tile(int L, int nM, int nN, int& pm, int& pn) {
    const int nwg = nM * nN; int wgid = L;
    { const int q = nwg / 8, r = nwg % 8, xcd = wgid % 8, off = wgid / 8; wgid = (xcd < r ? xcd * (q + 1) : r * (q + 1) + (xcd - r) * q) + off; }
    const int nig = 8 * nN, gid = wgid / nig, fm = gid * 8, gsz = (nM - fm) < 8 ? (nM - fm) : 8;
    pm = fm + ((wgid % nig) % gsz); pn = (wgid % nig) / gsz;
}

template <class Epi, class Sched, bool JUMP>
__device__ __forceinline__ void gemm_phase(LAS unsigned char* lds, const Cfg cfg, const Sched& S, const Epi& E) {
    const int tid = threadIdx.x, wid = __builtin_amdgcn_readfirstlane(tid >> 6), lane = tid & 63, wr = wid >> 2, wc = wid & 3, fr = lane & 15, fq = lane >> 4;
    unsigned voffA[2], voffB[2];
#pragma unroll
    for (int i = 0; i < 2; ++i) { int R, C; stage_rc(tid * 16 + i * 8192, R, C); const int Rb = Epi::PERM ? ((R & ~31) + perm32(R & 31)) : R;
        voffA[i] = (unsigned)(R * cfg.lda + C) * 2u; voffB[i] = (unsigned)(Rb * cfg.ldb + C) * 2u; }
    const size_t kstep = (size_t)(BK * 2);
    const size_t hsA = cfg.hstepA, hsB = cfg.hstepB;
    const unsigned ldsw = (unsigned)wid * 1024u;
    const int aoff = lds_byte(wr * 64 + fr, fq * 8), boff = lds_byte(wc * 32 + fr, fq * 8);
#define G8_SA(b, h) (((b) * 2 + (h)) * HTB)
#define G8_SB(b, h) ((4 + (b) * 2 + (h)) * HTB)
#define G8_STAGE(bufoff, gbase, voff) do { _Pragma("unroll") for (int _i = 0; _i < 2; ++_i) \
        __builtin_amdgcn_global_load_lds((const unsigned*)((const char*)(gbase) + (voff)[_i]), (LAS unsigned*)(lds + (bufoff) + ldsw + _i * 8192), 16, 0, 0); } while (0)
#define G8_LDA(dst, b, h) do { _Pragma("unroll") for (int m = 0; m < 4; ++m) _Pragma("unroll") for (int k = 0; k < 2; ++k) dst[m][k] = *(const LAS bf16x8*)(lds + G8_SA(b, h) + aoff + m * 2048 + k * 1024); } while (0)
#define G8_LDB(dst, b, h) do { _Pragma("unroll") for (int n = 0; n < 2; ++n) _Pragma("unroll") for (int k = 0; k < 2; ++k) dst[n][k] = *(const LAS bf16x8*)(lds + G8_SB(b, h) + boff + n * 2048 + k * 1024); } while (0)
#define G8_MMA(ai, bj, At, Bt) do { __builtin_amdgcn_s_setprio(1); _Pragma("unroll") for (int m = 0; m < 4; ++m) _Pragma("unroll") for (int n = 0; n < 2; ++n) _Pragma("unroll") for (int k = 0; k < 2; ++k) \
        acc[ai][bj][m][n] = __builtin_amdgcn_mfma_f32_16x16x32_bf16(Bt[n][k], At[m][k], acc[ai][bj][m][n], 0, 0, 0); __builtin_amdgcn_s_setprio(0); } while (0)
#define G8_WAIT_V(n) asm volatile("s_waitcnt vmcnt(" #n ")" ::: "memory")
#define G8_WAIT_L(n) asm volatile("s_waitcnt lgkmcnt(" #n ")" ::: "memory")
#define G8_BAR __builtin_amdgcn_s_barrier()
#define G8_SCHED __builtin_amdgcn_sched_barrier(0)
#define G8_KA(u, t) ((size_t)(t) * kstep + ((JUMP && (t) >= (u).nt1) ? (size_t)(long)(u).jumpA : (size_t)0))
#define G8_KB(u, t) ((size_t)(t) * kstep + ((JUMP && (t) >= (u).nt1) ? (size_t)(long)(u).jumpB : (size_t)0))
    Unit cur, nxt; int ui = 0;
    if (!S.next(0, cur)) return;
    f32x4 acc[2][2][4][2];
#pragma unroll
    for (int a = 0; a < 2; ++a)
#pragma unroll
        for (int b = 0; b < 2; ++b)
#pragma unroll
            for (int m = 0; m < 4; ++m)
#pragma unroll
                for (int n = 0; n < 2; ++n) acc[a][b][m][n] = (f32x4){0.f, 0.f, 0.f, 0.f};
    bf16x8 At[4][2], B0[2][2], B1[2][2];
    const char* cA = cur.A; const char* cB = cur.B;
    G8_STAGE(G8_SB(0, 0), cB, voffB); G8_STAGE(G8_SB(0, 1), cB + hsB, voffB); G8_STAGE(G8_SA(0, 0), cA, voffA); G8_STAGE(G8_SA(0, 1), cA + hsA, voffA);
    if (wr == 1) G8_BAR;
    G8_WAIT_V(2); G8_BAR;
    G8_STAGE(G8_SB(1, 0), cB + kstep, voffB); G8_STAGE(G8_SA(1, 0), cA + kstep, voffA); G8_STAGE(G8_SB(1, 1), cB + hsB + kstep, voffB);
    G8_WAIT_V(6); G8_BAR;
    for (;;) {
        const bool has_next = S.next(ui + 1, nxt);
        const char* nA = has_next ? nxt.A : cA; const char* nB = has_next ? nxt.B : cB;
        const int nt = cur.nt;
        for (int t = 0; t < nt; t += 2) {
            const bool last = (t == nt - 2);
            const char* a1 = cA + G8_KA(cur, t + 1);
            const char* a2 = last ? nA : cA + G8_KA(cur, t + 2); const char* b2 = last ? nB : cB + G8_KB(cur, t + 2);
            const char* a3 = last ? nA + kstep : cA + G8_KA(cur, t + 3); const char* b3 = last ? nB + kstep : cB + G8_KB(cur, t + 3);
            G8_LDB(B0, 0, 0); G8_LDB(B1, 0, 1); G8_SCHED; G8_LDA(At, 0, 0); G8_STAGE(G8_SA(1, 1), a1 + hsA, voffA);
            G8_WAIT_V(8); G8_WAIT_L(0); G8_BAR; G8_MMA(0, 0, At, B0); G8_MMA(0, 1, At, B1); G8_BAR; G8_SCHED;
            G8_LDA(At, 0, 1); G8_STAGE(G8_SB(0, 0), b2, voffB); G8_STAGE(G8_SB(0, 1), b2 + hsB, voffB); G8_STAGE(G8_SA(0, 0), a2, voffA);
            G8_WAIT_V(8); G8_WAIT_L(0); G8_BAR; G8_MMA(1, 0, At, B0); G8_MMA(1, 1, At, B1); G8_BAR; G8_SCHED;
            G8_LDB(B0, 1, 0); G8_LDB(B1, 1, 1); G8_SCHED; G8_LDA(At, 1, 0); G8_STAGE(G8_SA(0, 1), a2 + hsA, voffA);
            G8_WAIT_V(8); G8_WAIT_L(0); G8_BAR; G8_MMA(0, 0, At, B0); G8_MMA(0, 1, At, B1); G8_BAR; G8_SCHED;
            G8_LDA(At, 1, 1); G8_STAGE(G8_SB(1, 0), b3, voffB); G8_STAGE(G8_SB(1, 1), b3 + hsB, voffB); G8_STAGE(G8_SA(1, 0), a3, voffA);
            G8_WAIT_V(8); G8_WAIT_L(0); G8_BAR; G8_MMA(1, 0, At, B0); G8_MMA(1, 1, At, B1); G8_BAR; G8_SCHED;
        }
        if (wr == 0) G8_BAR;
        E(acc, cur, wr, wc, fr, fq, lds);
        if (!has_next) break;
#pragma unroll
        for (int a = 0; a < 2; ++a)
#pragma unroll
            for (int b = 0; b < 2; ++b)
#pragma unroll
                for (int m = 0; m < 4; ++m)
#pragma unroll
                    for (int n = 0; n < 2; ++n) acc[a][b][m][n] = (f32x4){0.f, 0.f, 0.f, 0.f};
        cur = nxt; cA = nA; cB = nB; ++ui;
        if (wr == 1) G8_BAR;
    }
    G8_WAIT_V(0);
    G8_BAR;
#undef G8_SA
#undef G8_SB
#undef G8_STAGE
#undef G8_LDA
#undef G8_LDB
#undef G8_MMA
#undef G8_WAIT_V
#undef G8_WAIT_L
#undef G8_BAR
#undef G8_SCHED
#undef G8_KA
#undef G8_KB
}
}
namespace g8 {
constexpr int EPI_SCR = STAGE_BYTES;

__device__ __forceinline__ float row_rstd(const float* ss, int nparts, int stride, int row) {
    float s = ss[row];
    for (int i = 1; i < nparts; ++i) s += ss[(size_t)i * stride + row];
    return rsqrtf(s * (1.f / D_MODEL) + EPS);
}

struct EpiSwiglu {
    static constexpr bool PERM = true;
    bf16_t* H; const float* ss; int nparts;
    __device__ __forceinline__ void operator()(const f32x4 (&acc)[2][2][4][2], const Unit& u, int wr, int wc, int fr, int fq, LAS unsigned char*) const {
#pragma unroll
        for (int ai = 0; ai < 2; ++ai)
#pragma unroll
            for (int m = 0; m < 4; ++m) {
                const int row = u.pm * BM + ai * HALF + wr * 64 + m * 16 + fr;
                const float r = row_rstd(ss, nparts, MTOK, row);
                float hv[8];
#pragma unroll
                for (int n = 0; n < 2; ++n)
#pragma unroll
                    for (int j = 0; j < 4; ++j) { const float a = acc[ai][0][m][n][j] * r, b = acc[ai][1][m][n][j] * r; hv[n * 4 + j] = a * fast_sigmoid(a) * b; }
                u32x4 w; w.x = cvt_pk_bf16(hv[0], hv[1]); w.y = cvt_pk_bf16(hv[2], hv[3]); w.z = cvt_pk_bf16(hv[4], hv[5]); w.w = cvt_pk_bf16(hv[6], hv[7]);
                *(u32x4*)(H + (size_t)row * D_FF + u.pn * 128 + wc * 32 + fq * 8) = w;
            }
    }
};

struct EpiResid {
    static constexpr bool PERM = false;
    const float* xres; float* xout; bf16_t* xb; float* ssout; float alpha;
    __device__ __forceinline__ void operator()(const f32x4 (&acc)[2][2][4][2], const Unit& u, int wr, int wc, int fr, int fq, LAS unsigned char* lds) const {
        LAS float* scr = (LAS float*)(lds + EPI_SCR);
#pragma unroll
        for (int ai = 0; ai < 2; ++ai)
#pragma unroll
            for (int m = 0; m < 4; ++m) {
                const int lrow = ai * HALF + wr * 64 + m * 16 + fr; const size_t row = (size_t)u.pm * BM + lrow;
                float sq = 0.f;
#pragma unroll
                for (int bj = 0; bj < 2; ++bj)
#pragma unroll
                    for (int n = 0; n < 2; ++n) {
                        const size_t off = row * D_MODEL + u.pn * BM + bj * HALF + wc * 32 + n * 16 + fq * 4;
                        const f32x4 xr = *(const f32x4*)(xres + off); f32x4 o = xr + acc[ai][bj][m][n] * alpha;
                        *(f32x4*)(xout + off) = o; sq += (o[0] * o[0] + o[1] * o[1]) + (o[2] * o[2] + o[3] * o[3]);
                        u32x2 w; w.x = cvt_pk_bf16(o[0], o[1]); w.y = cvt_pk_bf16(o[2], o[3]); *(u32x2*)(xb + off) = w;
                    }
                sq += __shfl_xor(sq, 16); sq += __shfl_xor(sq, 32);
                if (fq == 0) scr[lrow * 4 + wc] = sq;
            }
        asm volatile("s_waitcnt lgkmcnt(0)" ::: "memory"); __builtin_amdgcn_s_barrier(); asm volatile("" ::: "memory");
        if (threadIdx.x < 256) { const int lrow = threadIdx.x; const f32x4 p = *(const LAS f32x4*)(scr + lrow * 4);
            ssout[(size_t)u.pn * MTOK + (size_t)u.pm * BM + lrow] = (p[0] + p[1]) + (p[2] + p[3]); }
        asm volatile("s_waitcnt lgkmcnt(0)" ::: "memory"); __builtin_amdgcn_s_barrier(); asm volatile("" ::: "memory");
    }
};

struct EpiProj {
    static constexpr bool PERM = true;
    const float* ss2; const float* ssm; bf16_t *AG, *QKV, *XQ, *GATE, *MEMKV;
    __device__ __forceinline__ void operator()(const f32x4 (&acc)[2][2][4][2], const Unit& u, int wr, int wc, int fr, int fq, LAS unsigned char*) const {
        const int pn = u.pn; const bool is_mem = (u.aux != 0);
        int kind; bf16_t* dst; int pitch; float scale = 1.f;
        if (is_mem) { kind = 0; dst = MEMKV + pn * 256; pitch = 1024; }
        else if (pn < 2) { kind = 2; dst = AG; pitch = 0; }
        else if (pn < 11) { kind = 0; dst = QKV + (pn - 2) * 256; pitch = QKV_PITCH; if (pn < 5) scale = 0.125f * LOG2E; }
        else if (pn < 13) { kind = 0; dst = XQ + (pn - 11) * 256; pitch = 512; scale = 0.08838834764831845f * LOG2E; }
        else { kind = 1; const int gi = (pn - 13) >> 2; dst = GATE + (size_t)gi * MTOK * D_MODEL + ((pn - 13) & 3) * 256; pitch = 1024; }
#pragma unroll
        for (int ai = 0; ai < 2; ++ai)
#pragma unroll
            for (int m = 0; m < 4; ++m) {
                const int row = u.pm * BM + ai * HALF + wr * 64 + m * 16 + fr;
                const float r = (is_mem ? rsqrtf(ssm[row] * (1.f / D_MODEL) + EPS) : row_rstd(ss2, 4, MTOK, row)) * scale;
#pragma unroll
                for (int bj = 0; bj < 2; ++bj) {
                    float v[8];
#pragma unroll
                    for (int n = 0; n < 2; ++n)
#pragma unroll
                        for (int j = 0; j < 4; ++j) { float x = acc[ai][bj][m][n][j] * r; if (kind == 1) x = fast_sigmoid(x); v[n * 4 + j] = x; }
                    u32x4 w; w.x = cvt_pk_bf16(v[0], v[1]); w.y = cvt_pk_bf16(v[2], v[3]); w.z = cvt_pk_bf16(v[4], v[5]); w.w = cvt_pk_bf16(v[6], v[7]);
                    const int col = bj * HALF + wc * 32 + fq * 8;
                    bf16_t* p;
                    if (kind == 2) { const int ch = pn * 256 + col, g = ch >> 4, h0 = ch & 15; const int b = row >> 13, l = row & 8191, c = l >> 6, t = l & 63;
                        p = AG + ((size_t)(g * 512 + b * 128 + c) * AG_PITCH + t * 16 + h0); }
                    else p = dst + (size_t)row * pitch + col;
                    *(u32x4*)p = w;
                }
            }
    }
};

struct EpiSloc {
    static constexpr bool PERM = false;
    float* SLOC;
    __device__ __forceinline__ void operator()(const f32x4 (&acc)[2][2][4][2], const Unit& u, int wr, int wc, int fr, int fq, LAS unsigned char*) const {
#pragma unroll
        for (int ai = 0; ai < 2; ++ai)
#pragma unroll
            for (int m = 0; m < 4; ++m) {
                const int row = u.pm * BM + ai * HALF + wr * 64 + m * 16 + fr;
#pragma unroll
                for (int n = 0; n < 2; ++n) *(f32x4*)(SLOC + (size_t)row * 128 + wc * 32 + n * 16 + fq * 4) = acc[ai][0][m][n];
            }
    }
};

struct EpiY {
    static constexpr bool PERM = true;
    bf16_t* Y;
    __device__ __forceinline__ void operator()(const f32x4 (&acc)[2][2][4][2], const Unit& u, int wr, int wc, int fr, int fq, LAS unsigned char*) const {
        const int g = u.pm >> 1, rt = u.pm & 1, j = u.pn;
#pragma unroll
        for (int ai = 0; ai < 2; ++ai)
#pragma unroll
            for (int m = 0; m < 4; ++m) {
                const int r = rt * 256 + ai * HALF + wr * 64 + m * 16 + fr; const int b = r >> 7, c = r & 127;
#pragma unroll
                for (int bj = 0; bj < 2; ++bj) {
                    const int col = bj * HALF + wc * 32 + fq * 8, tl = col >> 4, h0 = col & 15; const int tok = b * SEQ + c * 64 + j * 16 + tl;
                    float v[8];
#pragma unroll
                    for (int n = 0; n < 2; ++n)
#pragma unroll
                        for (int q = 0; q < 4; ++q) v[n * 4 + q] = gelu_tanh_f(acc[ai][bj][m][n][q]);
                    u32x4 w; w.x = cvt_pk_bf16(v[0], v[1]); w.y = cvt_pk_bf16(v[2], v[3]); w.z = cvt_pk_bf16(v[4], v[5]); w.w = cvt_pk_bf16(v[6], v[7]);
                    *(u32x4*)(Y + (size_t)tok * QKV_PITCH + g * 16 + h0) = w;
                }
            }
    }
};

template <int MODE> struct EpiMerge {
    static constexpr bool PERM = true;
    const bf16_t* gate; bf16_t* merged;
    __device__ __forceinline__ void operator()(const f32x4 (&acc)[2][2][4][2], const Unit& u, int wr, int wc, int fr, int fq, LAS unsigned char*) const {
#pragma unroll
        for (int ai = 0; ai < 2; ++ai)
#pragma unroll
            for (int m = 0; m < 4; ++m) {
                const size_t row = (size_t)u.pm * BM + ai * HALF + wr * 64 + m * 16 + fr;
#pragma unroll
                for (int bj = 0; bj < (MODE == 2 ? 1 : 2); ++bj) {
                    const size_t off = row * D_MODEL + (MODE == 2 ? u.pn * 128 : u.pn * BM + bj * HALF) + wc * 32 + fq * 8;
                    float v[8];
#pragma unroll
                    for (int n = 0; n < 2; ++n)
#pragma unroll
                        for (int q = 0; q < 4; ++q) v[n * 4 + q] = (MODE == 2) ? acc[ai][0][m][n][q] * fast_sigmoid(acc[ai][1][m][n][q]) : acc[ai][bj][m][n][q];
                    const u32x4 gw = *(const u32x4*)(gate + off);
                    float o[8];
#pragma unroll
                    for (int q = 0; q < 4; ++q) { o[2 * q] = bf_lo(gw[q]) * v[2 * q]; o[2 * q + 1] = bf_hi(gw[q]) * v[2 * q + 1]; }
                    if (MODE != 0) { const u32x4 mw = *(const u32x4*)(merged + off);
#pragma unroll
                        for (int q = 0; q < 4; ++q) { o[2 * q] += bf_lo(mw[q]); o[2 * q + 1] += bf_hi(mw[q]); } }
                    u32x4 w; w.x = cvt_pk_bf16(o[0], o[1]); w.y = cvt_pk_bf16(o[2], o[3]); w.z = cvt_pk_bf16(o[4], o[5]); w.w = cvt_pk_bf16(o[6], o[7]);
                    *(u32x4*)(merged + off) = w;
                }
            }
    }
};

struct OrdDense {
    const char* A; const char* B; int nM, nN, nt, G, c; size_t tstepA, tstepB;
    __device__ __forceinline__ bool next(int i, Unit& u) const {
        const long L = (long)i * G + c; if (L >= (long)nM * nN) return false;
        decode_tile((int)L, nM, nN, u.pm, u.pn); u.A = A + (size_t)u.pm * tstepA; u.B = B + (size_t)u.pn * tstepB; u.aux = 0; u.nt = nt; u.nt1 = nt; u.jumpA = 0; u.jumpB = 0; return true;
    }
};
struct OrdProj {
    const char *A, *B, *Am, *Bm; int G, c;
    __device__ __forceinline__ bool next(int i, Unit& u) const {
        const long L = (long)i * G + c; u.nt = 16; u.nt1 = 16; u.jumpA = 0; u.jumpB = 0;
        if (L < 3200) { decode_tile((int)L, 128, 25, u.pm, u.pn); u.A = A + (size_t)u.pm * (256 * 1024 * 2); u.B = B + (size_t)u.pn * (256 * 1024 * 2); u.aux = 0; return true; }
        if (L < 3216) { const int x = (int)L - 3200; u.pm = x >> 2; u.pn = x & 3; u.A = Am + (size_t)u.pm * (256 * 1024 * 2); u.B = Bm + (size_t)u.pn * (256 * 1024 * 2); u.aux = 1; return true; }
        return false;
    }
};
struct OrdSloc {
    const char *AG, *QT; int G, c;
    __device__ __forceinline__ bool next(int i, Unit& u) const {
        const long L = (long)i * G + c; if (L >= 64) return false;
        u.pm = (int)L; u.pn = 0; u.A = AG + (size_t)u.pm * (256 * AG_PITCH * 2); u.B = QT + (size_t)(u.pm >> 1) * (128 * 1024 * 2); u.aux = 0; u.nt = 16; u.nt1 = 16; u.jumpA = 0; u.jumpB = 0; return true;
    }
};
struct OrdY {
    const char *AG, *LP; int G, c;
    __device__ __forceinline__ bool next(int i, Unit& u) const {
        const long L = (long)i * G + c; if (L >= 256) return false;
        const int j = 3 - (int)(L >> 6), pm = (int)(L & 63);
        u.pm = pm; u.pn = j; u.aux = 0; u.A = AG + (size_t)pm * (256 * AG_PITCH * 2); u.B = LP + (size_t)(pm >> 1) * (256 * LP_PITCH * 2) + (size_t)(48 - 16 * j) * 16 * 2;
        u.nt1 = 4 * (j + 1); u.nt = u.nt1 + 2; u.jumpA = (1024 - 256 * (j + 1)) * 2; u.jumpB = (1024 + 128 * j - ((48 - 16 * j) * 16 + 256 * (j + 1))) * 2; return true;
    }
};
}
namespace att {
__device__ __forceinline__ int crow(int r, int hi) { return (r & 3) + 8 * (r >> 2) + 4 * hi; }
__device__ __forceinline__ s16x4 vtr(const LAS char* p) { typedef short v4i16_t __attribute__((ext_vector_type(4))); return __builtin_bit_cast(s16x4, __builtin_amdgcn_ds_read_tr16_b64_v4i16((LAS v4i16_t*)p)); }

template <int D, int NKT, bool BAND>
__device__ __forceinline__ void attn_wave(const LAS char* Kl, const LAS char* Vl, int krow0, const bf16x8 (&qf)[D / 16], const LAS float* biasL, int valid_from,
                                          f32x16 (&o)[D / 32], float& m_out, float& l_out) {
    const int lane = threadIdx.x & 63, r = lane & 31, hh = lane >> 5;
    constexpr int RB = D * 2;
    float m = -INFINITY;
#pragma unroll 1
    for (int kt = 0; kt < NKT; ++kt) {
        const int krow = krow0 + 32 * kt + r; const LAS char* kp = Kl + krow * RB; const int sw = krow & 7;
        f32x16 s = {};
#pragma unroll
        for (int d0 = 0; d0 < D / 16; ++d0) { const bf16x8 kf = *(const LAS bf16x8*)(kp + (((2 * d0 + hh) ^ sw) << 4)); s = __builtin_amdgcn_mfma_f32_32x32x16_bf16(kf, qf[d0], s, 0, 0, 0); }
        float tm = -INFINITY;
#pragma unroll
        for (int rg = 0; rg < 16; ++rg) { float v = s[rg];
            if (BAND) { const int kl = crow(rg, hh), j = r + 128 - 32 * kt - kl; const bool ok = (j >= 0) && (j <= 128) && (krow0 + 32 * kt + kl >= valid_from); v = ok ? v + biasL[ok ? j : 0] : -INFINITY; }
            tm = fmaxf(tm, v); }
        m = fmaxf(m, tm);
    }
    m = fmaxf(m, __shfl_xor(m, 32));
    float l = 0.f;
#pragma unroll
    for (int db = 0; db < D / 32; ++db) o[db] = f32x16{};
    const int gi = lane >> 4, li = lane & 15;
    const int vcol = (16 * (gi & 1) + 4 * (li & 3)) * 2, vrow = 4 * (gi >> 1) + (li >> 2);
#pragma unroll 1
    for (int kt = 0; kt < NKT; ++kt) {
        const int krow = krow0 + 32 * kt + r; const LAS char* kp = Kl + krow * RB; const int sw = krow & 7;
        f32x16 s = {};
#pragma unroll
        for (int d0 = 0; d0 < D / 16; ++d0) { const bf16x8 kf = *(const LAS bf16x8*)(kp + (((2 * d0 + hh) ^ sw) << 4)); s = __builtin_amdgcn_mfma_f32_32x32x16_bf16(kf, qf[d0], s, 0, 0, 0); }
        float p[16]; float ps = 0.f;
#pragma unroll
        for (int rg = 0; rg < 16; ++rg) { float v = s[rg];
            if (BAND) { const int kl = crow(rg, hh), j = r + 128 - 32 * kt - kl; const bool ok = (j >= 0) && (j <= 128) && (krow0 + 32 * kt + kl >= valid_from); v = ok ? v + biasL[ok ? j : 0] : -INFINITY; }
            p[rg] = __builtin_amdgcn_exp2f(v - m); ps += p[rg]; }
        l += ps;
        u32x4 pw0, pw1;
        pw0.x = cvt_pk_bf16(p[0], p[1]); pw0.y = cvt_pk_bf16(p[2], p[3]); pw0.z = cvt_pk_bf16(p[4], p[5]); pw0.w = cvt_pk_bf16(p[6], p[7]);
        pw1.x = cvt_pk_bf16(p[8], p[9]); pw1.y = cvt_pk_bf16(p[10], p[11]); pw1.z = cvt_pk_bf16(p[12], p[13]); pw1.w = cvt_pk_bf16(p[14], p[15]);
        const bf16x8 pb0 = __builtin_bit_cast(bf16x8, pw0), pb1 = __builtin_bit_cast(bf16x8, pw1);
        const LAS char* vb = Vl + (krow0 + 32 * kt + vrow) * RB + vcol;
#pragma unroll
        for (int db = 0; db < D / 32; ++db) {
            const s16x4 a0 = vtr(vb + db * 64), a1 = vtr(vb + db * 64 + 8 * RB), a2 = vtr(vb + db * 64 + 16 * RB), a3 = vtr(vb + db * 64 + 24 * RB);
            const bf16x8 v0 = (bf16x8){a0[0], a0[1], a0[2], a0[3], a1[0], a1[1], a1[2], a1[3]}, v1 = (bf16x8){a2[0], a2[1], a2[2], a2[3], a3[0], a3[1], a3[2], a3[3]};
            o[db] = __builtin_amdgcn_mfma_f32_32x32x16_bf16(v0, pb0, o[db], 0, 0, 0);
            o[db] = __builtin_amdgcn_mfma_f32_32x32x16_bf16(v1, pb1, o[db], 0, 0, 0);
        }
    }
    l += __shfl_xor(l, 32);
    m_out = m; l_out = l;
}

template <int D> __device__ __forceinline__ void store_o(bf16_t* orow, const f32x16 (&o)[D / 32], float inv_l) {
    const int hh = (threadIdx.x & 63) >> 5;
#pragma unroll
    for (int db = 0; db < D / 32; ++db)
#pragma unroll
        for (int q4 = 0; q4 < 4; ++q4) { u32x2 w; w.x = cvt_pk_bf16(o[db][4 * q4] * inv_l, o[db][4 * q4 + 1] * inv_l); w.y = cvt_pk_bf16(o[db][4 * q4 + 2] * inv_l, o[db][4 * q4 + 3] * inv_l);
            *(u32x2*)(orow + 32 * db + 8 * q4 + 4 * hh) = w; }
}

__device__ const unsigned char BUCKETS[3][129] = {
{0,1,2,3,4,5,6,7,8,9,10,11,12,13,14,15,16,16,16,16,16,16,17,17,17,17,17,17,17,17,18,18,18,18,18,18,18,18,18,18,19,19,19,19,19,19,19,19,19,19,19,19,19,19,20,20,20,20,20,20,20,20,20,20,20,20,20,20,20,20,20,20,20,21,21,21,21,21,21,21,21,21,21,21,21,21,21,21,21,21,21,21,21,21,21,21,21,21,21,22,22,22,22,22,22,22,22,22,22,22,22,22,22,22,22,22,22,22,22,22,22,22,22,22,22,22,22,22,22},
{0,4,8,12,16,16,17,17,18,18,19,19,19,19,20,20,20,20,20,21,21,21,21,21,21,22,22,22,22,22,22,22,22,22,23,23,23,23,23,23,23,23,23,23,23,23,24,24,24,24,24,24,24,24,24,24,24,24,24,24,24,24,25,25,25,25,25,25,25,25,25,25,25,25,25,25,25,25,25,25,25,25,25,26,26,26,26,26,26,26,26,26,26,26,26,26,26,26,26,26,26,26,26,26,26,26,26,26,26,26,26,26,26,27,27,27,27,27,27,27,27,27,27,27,27,27,27,27,27},
{0,16,18,19,20,21,21,22,22,23,23,23,24,24,24,24,25,25,25,25,25,26,26,26,26,26,26,26,26,27,27,27,27,27,27,27,27,27,27,28,28,28,28,28,28,28,28,28,28,28,28,28,29,29,29,29,29,29,29,29,29,29,29,29,29,29,29,29,29,29,30,30,30,30,30,30,30,30,30,30,30,30,30,30,30,30,30,30,30,30,30,30,30,30,30,31,31,31,31,31,31,31,31,31,31,31,31,31,31,31,31,31,31,31,31,31,31,31,31,31,31,31,31,31,31,31,31,31,31}};

constexpr int LDS_K = 0, LDS_V = 65536, LDS_BIAS = 131072 + 4096;

__device__ __forceinline__ void dattn_unit(LAS unsigned char* lds, bf16_t* QKV, float* LSE, const float* rel, int b, int g, int h, int rs, int qt) {
    const int tid = threadIdx.x, lane = tid & 63, wid = __builtin_amdgcn_readfirstlane(tid >> 6), r = lane & 31, hh = lane >> 5;
    const int dil = (g == 0) ? 1 : (g == 1 ? 4 : 16);
    LAS char* Kl = (LAS char*)lds + LDS_K; LAS char* Vl = (LAS char*)lds + LDS_V; LAS float* biasL = (LAS float*)(lds + LDS_BIAS);
    const int nk0 = 256 * qt - 128;
    const size_t hcol = (size_t)g * 256 + h * 64;
#pragma unroll
    for (int i = 0; i < 6; ++i) { const int e = tid + 512 * i, row = e >> 3, ch = e & 7; const int nk = nk0 + row;
        u32x4 kv = {0u, 0u, 0u, 0u}, vv = {0u, 0u, 0u, 0u};
        if (nk >= 0) { const size_t tok = (size_t)b * SEQ + rs + (size_t)dil * nk; const bf16_t* src = QKV + tok * QKV_PITCH + hcol + ch * 8; kv = *(const u32x4*)(src + 768); vv = *(const u32x4*)(src + 1536); }
        *(LAS u32x4*)(Kl + row * 128 + ((ch ^ (row & 7)) << 4)) = kv; *(LAS u32x4*)(Vl + row * 128 + (ch << 4)) = vv; }
    if (tid < 129) biasL[tid] = rel[(int)BUCKETS[g][tid] * 12 + g * 4 + h] * LOG2E;
    const int nq = 256 * qt + 32 * wid + r; const size_t qtok = (size_t)b * SEQ + rs + (size_t)dil * nq; bf16_t* qrow = QKV + qtok * QKV_PITCH + hcol;
    bf16x8 qf[4];
#pragma unroll
    for (int s = 0; s < 4; ++s) qf[s] = *(const bf16x8*)(qrow + 16 * s + 8 * hh);
    __syncthreads();
    f32x16 o[2]; float m, l;
    attn_wave<64, 5, true>(Kl, Vl, 32 * wid, qf, biasL, (qt == 0) ? 128 : 0, o, m, l);
    store_o<64>(qrow, o, __builtin_amdgcn_rcpf(l));
    if (hh == 0) LSE[qtok * 12 + g * 4 + h] = m + __builtin_amdgcn_logf(l);
    __syncthreads();
}

__device__ __forceinline__ void xattn_unit(LAS unsigned char* lds, bf16_t* XQ, const bf16_t* MEMKV, int b, int hd, int qt) {
    const int tid = threadIdx.x, lane = tid & 63, wid = __builtin_amdgcn_readfirstlane(tid >> 6), r = lane & 31, hh = lane >> 5;
    LAS char* Kl = (LAS char*)lds + LDS_K; LAS char* Vl = (LAS char*)lds + LDS_V;
#pragma unroll
    for (int i = 0; i < 8; ++i) { const int e = tid + 512 * i, row = e >> 4, ch = e & 15; const bf16_t* src = MEMKV + (size_t)(b * MEM_LEN + row) * 1024 + hd * 128 + ch * 8;
        const u32x4 kv = *(const u32x4*)src, vv = *(const u32x4*)(src + 512);
        *(LAS u32x4*)(Kl + row * 256 + ((ch ^ (row & 7)) << 4)) = kv; *(LAS u32x4*)(Vl + row * 256 + (ch << 4)) = vv; }
    const size_t qtok = (size_t)b * SEQ + 256 * qt + 32 * wid + r; bf16_t* qrow = XQ + qtok * 512 + hd * 128;
    bf16x8 qf[8];
#pragma unroll
    for (int s = 0; s < 8; ++s) qf[s] = *(const bf16x8*)(qrow + 16 * s + 8 * hh);
    __syncthreads();
    f32x16 o[4]; float m, l;
    attn_wave<128, 8, false>(Kl, Vl, 0, qf, nullptr, 0, o, m, l);
    store_o<128>(qrow, o, __builtin_amdgcn_rcpf(l));
    __syncthreads();
}

__device__ __forceinline__ void combine_rows(bf16_t* QKV, const float* LSE, int gw, int ngw) {
    const int lane = threadIdx.x & 63; const int h = lane >> 4, c = (lane & 15) * 4;
    for (int tok = gw; tok < MTOK; tok += ngw) {
        const float l0 = LSE[(size_t)tok * 12 + h], l1 = LSE[(size_t)tok * 12 + 4 + h], l2 = LSE[(size_t)tok * 12 + 8 + h];
        const float mx = fmaxf(l0, fmaxf(l1, l2)); float w0 = __builtin_amdgcn_exp2f(l0 - mx), w1 = __builtin_amdgcn_exp2f(l1 - mx), w2 = __builtin_amdgcn_exp2f(l2 - mx);
        const float inv = __builtin_amdgcn_rcpf(w0 + w1 + w2); w0 *= inv; w1 *= inv; w2 *= inv;
        bf16_t* p = QKV + (size_t)tok * QKV_PITCH + h * 64 + c;
        const u32x2 a = *(const u32x2*)p, bq = *(const u32x2*)(p + 256), cq = *(const u32x2*)(p + 512);
        u32x2 w; w.x = cvt_pk_bf16(w0 * bf_lo(a.x) + w1 * bf_lo(bq.x) + w2 * bf_lo(cq.x), w0 * bf_hi(a.x) + w1 * bf_hi(bq.x) + w2 * bf_hi(cq.x));
        w.y = cvt_pk_bf16(w0 * bf_lo(a.y) + w1 * bf_lo(bq.y) + w2 * bf_lo(cq.y), w0 * bf_hi(a.y) + w1 * bf_hi(bq.y) + w2 * bf_hi(cq.y));
        *(u32x2*)p = w;
    }
}
}
namespace ssm {
constexpr int L_WP = 0, L_BB = L_WP + 65 * 64 * 2 * 4, L_CC = L_BB + 64 * 16 * 2 * 4, L_KT = L_CC + 16 * 64 * 2 * 4;
static_assert(L_KT + 64 * 256 * 4 <= 131072, "ssm lds");

__device__ __forceinline__ void build_group(LAS unsigned char* lds, int g, const float* a_re, const float* a_im, const float* log_dt, const float* b_re, const float* b_im,
                                            const float* c_re, const float* c_im, const float* dsk, bf16_t* LP, bf16_t* QT) {
    const int tid = threadIdx.x;
    LAS float* WP = (LAS float*)(lds + L_WP); LAS float* BB = (LAS float*)(lds + L_BB); LAS float* CC = (LAS float*)(lds + L_CC); LAS float* KT = (LAS float*)(lds + L_KT);
    const double dt = exp((double)log_dt[g]);
    for (int e = tid; e < 65 * 64; e += 512) { const int tau = e >> 6, p = e & 63; const double ar = a_re[g * 64 + p], ai = a_im[g * 64 + p];
        const double mag = exp(ar * dt * tau), ang = ai * dt * tau; WP[2 * (p * 65 + tau)] = (float)(mag * cos(ang)); WP[2 * (p * 65 + tau) + 1] = (float)(mag * sin(ang)); }
    for (int e = tid; e < 1024; e += 512) { const int p = e >> 4, h = e & 15; const double ar = a_re[g * 64 + p], ai = a_im[g * 64 + p];
        const double mag = exp(ar * dt), ang = ai * dt, abr = mag * cos(ang), abi = mag * sin(ang), nr = abr - 1.0, ni = abi, den = ar * ar + ai * ai;
        const double cr = (nr * ar + ni * ai) / den, ci = (ni * ar - nr * ai) / den; const double br = b_re[(g * 64 + p) * 16 + h], bi = b_im[(g * 64 + p) * 16 + h];
        BB[2 * e] = (float)(cr * br - ci * bi); BB[2 * e + 1] = (float)(cr * bi + ci * br);
        CC[2 * e] = c_re[(g * 16 + h) * 64 + p]; CC[2 * e + 1] = c_im[(g * 16 + h) * 64 + p]; }
    __syncthreads();
    for (int e = tid; e < 64 * 16; e += 512) { const int tau = e >> 4, h = e & 15; float s[16];
#pragma unroll
        for (int hp = 0; hp < 16; ++hp) s[hp] = 0.f;
        for (int p = 0; p < 64; ++p) { const f32x2 c = *(const LAS f32x2*)(CC + 2 * (p * 16 + h)), w = *(const LAS f32x2*)(WP + 2 * (p * 65 + tau));
            const float cwr = c.x * w.x - c.y * w.y, cwi = c.x * w.y + c.y * w.x;
#pragma unroll
            for (int hp = 0; hp < 16; ++hp) { const f32x2 bb = *(const LAS f32x2*)(BB + 2 * (p * 16 + hp)); s[hp] += cwr * bb.x - cwi * bb.y; } }
#pragma unroll
        for (int hp = 0; hp < 16; ++hp) KT[tau * 256 + h * 16 + hp] = s[hp] + ((tau == 0 && h == hp) ? dsk[g * 16 + h] : 0.f); }
    __syncthreads();
    bf16_t* lp = LP + (size_t)g * 256 * LP_PITCH;
    for (int e = tid; e < 256 * 128; e += 512) { const int n = e >> 7, c8 = e & 127, tl = n >> 4, h = n & 15, si = c8 >> 1, hp0 = (c8 & 1) * 8; const int tau = tl + 48 - si;
        u32x4 w = {0u, 0u, 0u, 0u};
        if (tau >= 0 && tau <= 63) { const LAS float* k = KT + tau * 256 + h * 16 + hp0; w.x = cvt_pk_bf16(k[0], k[1]); w.y = cvt_pk_bf16(k[2], k[3]); w.z = cvt_pk_bf16(k[4], k[5]); w.w = cvt_pk_bf16(k[6], k[7]); }
        *(u32x4*)(lp + (size_t)n * LP_PITCH + c8 * 8) = w; }
    for (int e = tid; e < 256 * 64; e += 512) { const int n = e >> 6, q = e & 63, j = q >> 4, p0 = (q & 15) * 4, tl = n >> 4, h = n & 15, tau = 16 * j + tl + 1; float v[8];
#pragma unroll
        for (int i = 0; i < 4; ++i) { const int p = p0 + i; const float cr = CC[2 * (p * 16 + h)], ci = CC[2 * (p * 16 + h) + 1], wr = WP[2 * (p * 65 + tau)], wi = WP[2 * (p * 65 + tau) + 1];
            v[2 * i] = cr * wr - ci * wi; v[2 * i + 1] = -(cr * wi + ci * wr); }
        u32x4 w; w.x = cvt_pk_bf16(v[0], v[1]); w.y = cvt_pk_bf16(v[2], v[3]); w.z = cvt_pk_bf16(v[4], v[5]); w.w = cvt_pk_bf16(v[6], v[7]);
        *(u32x4*)(lp + (size_t)n * LP_PITCH + 1024 + 128 * j + 2 * p0) = w; }
    bf16_t* qt = QT + (size_t)g * 128 * 1024;
    for (int e = tid; e < 128 * 128; e += 512) { const int rw = e >> 7, c8 = e & 127, p = rw >> 1, ri = rw & 1, s = c8 >> 1, hp0 = (c8 & 1) * 8; const int tau = 63 - s;
        const float wr = WP[2 * (p * 65 + tau)], wi = WP[2 * (p * 65 + tau) + 1]; float v[8];
#pragma unroll
        for (int i = 0; i < 8; ++i) { const float br = BB[2 * (p * 16 + hp0 + i)], bi = BB[2 * (p * 16 + hp0 + i) + 1]; v[i] = ri ? (wr * bi + wi * br) : (wr * br - wi * bi); }
        u32x4 w; w.x = cvt_pk_bf16(v[0], v[1]); w.y = cvt_pk_bf16(v[2], v[3]); w.z = cvt_pk_bf16(v[4], v[5]); w.w = cvt_pk_bf16(v[6], v[7]);
        *(u32x4*)(qt + (size_t)rw * 1024 + c8 * 8) = w; }
    __syncthreads();
}

__device__ __forceinline__ void carry_scan(int gthread, const float* a_re, const float* a_im, const float* log_dt, const float* SLOC, bf16_t* AG) {
    if (gthread >= 32 * 4 * 64) return;
    const int p = gthread & 63, b = (gthread >> 6) & 3, g = gthread >> 8;
    const double dt = exp((double)log_dt[g]); const double ar = a_re[g * 64 + p], ai = a_im[g * 64 + p]; const double mag = exp(ar * dt * 64.0), ang = ai * dt * 64.0;
    const float wr = (float)(mag * cos(ang)), wi = (float)(mag * sin(ang));
    float xr = 0.f, xi = 0.f;
    const f32x2* sl = (const f32x2*)(SLOC + ((size_t)g * 512 + b * 128) * 128) + p; unsigned* xo = (unsigned*)(AG + ((size_t)g * 512 + b * 128) * AG_PITCH + 1024) + p;
    for (int c0 = 0; c0 < 128; c0 += 8) {
        f32x2 s[8];
#pragma unroll
        for (int i = 0; i < 8; ++i) s[i] = sl[(size_t)(c0 + i) * 64];
#pragma unroll
        for (int i = 0; i < 8; ++i) { xo[(size_t)(c0 + i) * (AG_PITCH / 2)] = cvt_pk_bf16(xr, xi); const float nr = wr * xr - wi * xi + s[i].x, ni = wr * xi + wi * xr + s[i].y; xr = nr; xi = ni; }
    }
}
}

namespace prep {
__device__ __forceinline__ void transpose_item(const float* W, int K, int N, bf16_t* WT, int half, const float* gain, LAS float* scr, int item, int lane) {
    const int nblk = N / 32, kb = item / nblk, nb = item % nblk, k0 = 64 * kb, n0 = 32 * nb;
#pragma unroll 8
    for (int i = 0; i < 32; ++i) { const int kk = 2 * i + (lane >> 5); float v = W[(size_t)(k0 + kk) * N + n0 + (lane & 31)]; if (gain) v *= gain[k0 + kk]; scr[kk * 33 + (lane & 31)] = v; }
    asm volatile("s_waitcnt lgkmcnt(0)" ::: "memory");
    const int c = lane & 7;
#pragma unroll
    for (int j = 0; j < 4; ++j) { const int nl = (lane >> 3) + 8 * j; const LAS float* s = scr + (8 * c) * 33 + nl; int n = n0 + nl, row = n;
        if (half > 0) { const int isb = n >= half; const int cc = isb ? n - half : n; row = (cc >> 7) * 256 + (isb ? 128 : 0) + (cc & 127); }
        u32x4 o; o.x = cvt_pk_bf16(s[0 * 33], s[1 * 33]); o.y = cvt_pk_bf16(s[2 * 33], s[3 * 33]); o.z = cvt_pk_bf16(s[4 * 33], s[5 * 33]); o.w = cvt_pk_bf16(s[6 * 33], s[7 * 33]);
        *(u32x4*)(WT + (size_t)row * K + k0 + 8 * c) = o; }
    asm volatile("s_waitcnt lgkmcnt(0)" ::: "memory");
}
__device__ __forceinline__ void row_to_bf16(const float* xrow, bf16_t* orow, float* ss, int lane) {
    const f32x4* xr = (const f32x4*)xrow + lane; f32x4 v[4]; float s = 0.f;
#pragma unroll
    for (int j = 0; j < 4; ++j) { v[j] = xr[64 * j]; s += (v[j][0] * v[j][0] + v[j][1] * v[j][1]) + (v[j][2] * v[j][2] + v[j][3] * v[j][3]); }
    s = wave_sum(s);
    u32x2* o8 = (u32x2*)orow + lane;
#pragma unroll
    for (int j = 0; j < 4; ++j) { u32x2 w; w.x = cvt_pk_bf16(v[j][0], v[j][1]); w.y = cvt_pk_bf16(v[j][2], v[j][3]); o8[64 * j] = w; }
    if (lane == 0) *ss = s;
}
__device__ __forceinline__ void final_row(float* xrow, const float* ss4, int row, const float* gain, int lane) {
    const float r = rsqrtf(((ss4[row] + ss4[MTOK + row]) + (ss4[2 * MTOK + row] + ss4[3 * MTOK + row])) * (1.f / D_MODEL) + EPS);
    f32x4* xr = (f32x4*)xrow + lane; const f32x4* gr = (const f32x4*)gain + lane;
#pragma unroll
    for (int j = 0; j < 4; ++j) { const f32x4 v = xr[64 * j], g = gr[64 * j]; xr[64 * j] = v * r * g; }
}
}
#define RLX_AGENT __ATOMIC_RELAXED, __HIP_MEMORY_SCOPE_AGENT
#define XB_TMO      128
#define XB_XCNT(j)  (256  + 64 * (j))
#define XB_XSUB(j)  (1280 + 64 * (j))
#define XB_XGEN(j)  (2304 + 64 * (j))
#define XB_TOP      3328
#define XB_TOPGEN   3392
#define XCD_BAR_WORDS 3456
#define XB_SPIN_CAP (1u << 22)
__device__ __forceinline__ unsigned xb_ld(unsigned* p)              { return __hip_atomic_load(p, __ATOMIC_RELAXED, __HIP_MEMORY_SCOPE_AGENT); }
__device__ __forceinline__ unsigned xb_add(unsigned* p, unsigned v) { return __hip_atomic_fetch_add(p, v, __ATOMIC_RELAXED, __HIP_MEMORY_SCOPE_AGENT); }
__device__ __forceinline__ unsigned xb_xcc_id() { return (unsigned)__builtin_amdgcn_s_getreg((3 << 11) | 20) & 0xFu; }
#define XB_SPIN(cond, bar) do { unsigned _sp = 0; while (cond) { __builtin_amdgcn_s_sleep(1); \
    if ((++_sp & 255u) == 0u) { if (xb_ld(&(bar)[XB_TMO])) break; if (_sp > XB_SPIN_CAP) { atomicAdd(&(bar)[XB_TMO], 1u); break; } } } } while (0)
struct XcdBarrier { unsigned* bar; unsigned x; volatile LAS unsigned* st; };
__device__ __forceinline__ XcdBarrier xcd_barrier_post(unsigned* bar, volatile LAS unsigned* st) {
    XcdBarrier b; b.bar = bar; b.x = xb_xcc_id(); b.st = st;
    if (threadIdx.x == 0) (void)xb_add(&bar[XB_XCNT(b.x)], 1u);
    return b;
}
__device__ __forceinline__ void xcd_barrier_complete(unsigned* bar, unsigned x, unsigned& nloc, unsigned& nx) {
    const unsigned G = gridDim.x * gridDim.y * gridDim.z;
    unsigned sum, cnt, mine, sp = 0u;
    for (;;) {
        sum = 0u; cnt = 0u; mine = 0u;
#pragma unroll
        for (unsigned j = 0; j < 16; ++j) { const unsigned c = xb_ld(&bar[XB_XCNT(j)]); sum += c; cnt += (c > 0u) ? 1u : 0u; mine = (j == x) ? c : mine; }
        if (sum == G) break;
        __builtin_amdgcn_s_sleep(1);
        if ((++sp & 255u) == 0u) { if (xb_ld(&bar[XB_TMO])) break; if (sp > XB_SPIN_CAP) { atomicAdd(&bar[XB_TMO], 1u); break; } }
    }
    nloc = mine > 0u ? mine : 1u; nx = cnt > 0u ? cnt : 1u;
}
__device__ __forceinline__ void xcd_barrier(const XcdBarrier& b) {
    asm volatile("s_waitcnt vmcnt(0)" ::: "memory");
    __syncthreads();
    if (threadIdx.x == 0) {
        unsigned* bar = b.bar;
        __builtin_amdgcn_s_waitcnt(0);
        unsigned nloc = b.st[0], nx = b.st[1];
        if (nloc == 0u) { xcd_barrier_complete(bar, b.x, nloc, nx); b.st[0] = nloc; b.st[1] = nx; }
        const unsigned old = xb_add(&bar[XB_XSUB(b.x)], 1u);
        const unsigned gen = old / nloc;
        if (old + 1u == (gen + 1u) * nloc) {
            __builtin_amdgcn_fence(__ATOMIC_RELEASE, "agent");
            asm volatile("s_waitcnt vmcnt(0)" ::: "memory");
            const unsigned og = xb_add(&bar[XB_TOP], 1u);
            const unsigned tg = og / nx;
            if (og + 1u == (tg + 1u) * nx) xb_add(&bar[XB_TOPGEN], 1u);
            else XB_SPIN(xb_ld(&bar[XB_TOPGEN]) == tg, bar);
            __builtin_amdgcn_fence(__ATOMIC_ACQUIRE, "agent");
            xb_add(&bar[XB_XGEN(b.x)], 1u);
            asm volatile("s_waitcnt vmcnt(0)" ::: "memory");
        } else {
            XB_SPIN(xb_ld(&bar[XB_XGEN(b.x)]) == gen, bar);
            __builtin_amdgcn_fence(__ATOMIC_ACQUIRE, "agent");
            asm volatile("s_waitcnt vmcnt(0)" ::: "memory");
        }
    }
    __syncthreads();
}

constexpr int LDS_STAGE = 0;
constexpr int LDS_EPI = 131072;
constexpr int LDS_BIASTAB = 131072 + 4096;
constexpr int LDS_MISC = 131072 + 4096 + 1024;
constexpr int LDS_BYTES = 147456;
constexpr int NPHASE = 15;

struct Args { const float* in[26]; float* out; unsigned char* ws; int ph_lo, ph_hi; };

__global__ void __launch_bounds__(512, 2) mega_fwd(Args args) {
    extern __shared__ __attribute__((aligned(16))) unsigned char lds_raw[];
    LAS unsigned char* lds = (LAS unsigned char*)lds_raw;
    const int tid = threadIdx.x, lane = tid & 63, wave = __builtin_amdgcn_readfirstlane(tid >> 6);
    const int G = gridDim.x, c = blockIdx.x;
    const int gw = c * 8 + wave, NGW = G * 8;
    unsigned char* ws = args.ws;
    const float* const* in = args.in;
    volatile LAS unsigned* MISC = (volatile LAS unsigned*)(lds + LDS_MISC);
    if (tid < 64) MISC[tid] = 0u;
    __syncthreads();
    const int lo = args.ph_lo, hi = args.ph_hi;
    const bool multi = (hi - lo) > 1;
    XcdBarrier bar; bar.bar = (unsigned*)(ws + WS_CTL); bar.x = 0; bar.st = nullptr;
    if (multi) bar = xcd_barrier_post((unsigned*)(ws + WS_CTL), MISC);
#define IN(k) (lo <= (k) && (k) < hi)
#define SEAM(k) do { if (IN(k) && IN((k) + 1)) xcd_barrier(bar); } while (0)

    float* OUT = args.out;
    float* SS1 = (float*)(ws + WS_SS1); float* SS2 = (float*)(ws + WS_SS2); float* SS3 = (float*)(ws + WS_SS3); float* SS4 = (float*)(ws + WS_SS4); float* SSMEM = (float*)(ws + WS_SSM);
    bf16_t* MEMB = (bf16_t*)(ws + WS_MEMB); bf16_t* MEMKV = (bf16_t*)(ws + WS_MEMKV);
    bf16_t* WIN = (bf16_t*)(ws + WS_WIN); bf16_t* WGLU = (bf16_t*)(ws + WS_WGLU); bf16_t* WAU = (bf16_t*)(ws + WS_WAU); bf16_t* WKV = (bf16_t*)(ws + WS_WKV);
    bf16_t* WMU = (bf16_t*)(ws + WS_WMU); bf16_t* WOUT = (bf16_t*)(ws + WS_WOUT); bf16_t* WFIN = (bf16_t*)(ws + WS_WFIN); bf16_t* WFDN = (bf16_t*)(ws + WS_WFDN);
    bf16_t* XB = (bf16_t*)(ws + WS_XB); bf16_t* LP = (bf16_t*)(ws + WS_LP); bf16_t* QT = (bf16_t*)(ws + WS_QT); float* SLOC = (float*)(ws + WS_SLOC); float* LSE = (float*)(ws + WS_LSE);
    bf16_t* HB = (bf16_t*)(ws + WS_H); bf16_t* QKV = (bf16_t*)(ws + WS_QKV); bf16_t* XQ = (bf16_t*)(ws + WS_XQ); bf16_t* AG = (bf16_t*)(ws + WS_AG); bf16_t* GATE = (bf16_t*)(ws + WS_GATE);
    bf16_t* GATE_S = GATE; bf16_t* MERGED = GATE + (size_t)MTOK * D_MODEL; bf16_t* GATE_M = GATE + 2 * (size_t)MTOK * D_MODEL;
    LAS float* scr = (LAS float*)(lds + LDS_STAGE + wave * 16384);

    if (IN(0)) {
        constexpr int I_FIN = 16 * 176, I_FDN = 44 * 32, I_WIN = 16 * 200, I_GLU = 8 * 64, I_AU = 4 * 32, I_KV = 16 * 32, I_MU = 8 * 32, I_OUT = 16 * 32;
        constexpr int NIT = I_FIN + I_FDN + I_WIN + I_GLU + I_AU + I_KV + I_MU + I_OUT;
        for (int it = gw; it < NIT; it += NGW) { int r = it;
            if (r < I_FIN) { prep::transpose_item(in[3], 1024, 5632, WFIN, 2816, in[2], scr, r, lane); continue; } r -= I_FIN;
            if (r < I_FDN) { prep::transpose_item(in[4], 2816, 1024, WFDN, 0, nullptr, scr, r, lane); continue; } r -= I_FDN;
            if (r < I_WIN) { prep::transpose_item(in[6], 1024, 6400, WIN, 0, in[5], scr, r, lane); continue; } r -= I_WIN;
            if (r < I_GLU) { prep::transpose_item(in[15], 512, 2048, WGLU, 1024, nullptr, scr, r, lane); continue; } r -= I_GLU;
            if (r < I_AU) { prep::transpose_item(in[17], 256, 1024, WAU, 0, nullptr, scr, r, lane); continue; } r -= I_AU;
            if (r < I_KV) { prep::transpose_item(in[19], 1024, 1024, WKV, 0, in[18], scr, r, lane); continue; } r -= I_KV;
            if (r < I_MU) { prep::transpose_item(in[20], 512, 1024, WMU, 0, nullptr, scr, r, lane); continue; } r -= I_MU;
            prep::transpose_item(in[21], 1024, 1024, WOUT, 0, nullptr, scr, r, lane);
        }
        for (int m = gw; m < MTOK; m += NGW) prep::row_to_bf16(in[0] + (size_t)m * D_MODEL, XB + (size_t)m * D_MODEL, SS1 + m, lane);
        for (int m = gw; m < MEMROWS; m += NGW) prep::row_to_bf16(in[1] + (size_t)m * D_MODEL, MEMB + (size_t)m * D_MODEL, SSMEM + m, lane);
    }
    SEAM(0);
    if (IN(1)) {
        g8::OrdDense S{(const char*)XB, (const char*)WFIN, 128, 22, 16, G, c, (size_t)256 * 1024 * 2, (size_t)256 * 1024 * 2};
        g8::EpiSwiglu E{HB, SS1, 1};
        g8::gemm_phase<g8::EpiSwiglu, g8::OrdDense, false>(lds, g8::Cfg{1024, 1024, (size_t)128 * 1024 * 2, (size_t)128 * 1024 * 2}, S, E);
    }
    SEAM(1);
    if (IN(2)) {
        g8::OrdDense S{(const char*)HB, (const char*)WFDN, 128, 4, 44, G, c, (size_t)256 * D_FF * 2, (size_t)256 * D_FF * 2};
        g8::EpiResid E{in[0], OUT, XB, SS2, 0.5f};
        g8::gemm_phase<g8::EpiResid, g8::OrdDense, false>(lds, g8::Cfg{D_FF, D_FF, (size_t)128 * D_FF * 2, (size_t)128 * D_FF * 2}, S, E);
    }
    SEAM(2);
    if (IN(3)) {
        g8::OrdProj S{(const char*)XB, (const char*)WIN, (const char*)MEMB, (const char*)WKV, G, c};
        g8::EpiProj E{SS2, SSMEM, AG, QKV, XQ, GATE, MEMKV};
        g8::gemm_phase<g8::EpiProj, g8::OrdProj, false>(lds, g8::Cfg{1024, 1024, (size_t)128 * 1024 * 2, (size_t)128 * 1024 * 2}, S, E);
    }
    SEAM(3);
    if (IN(4)) {
        if (c < 32) ssm::build_group(lds, c, in[7], in[8], in[9], in[10], in[11], in[12], in[13], in[14], LP, QT);
        for (int u = c; u < 1536; u += G) { const int x = u & 31, h = (u >> 5) & 3, rest = u >> 7, g = rest % 3, b = rest / 3; const int ntile = (g == 0) ? 32 : (g == 1 ? 8 : 2);
            att::dattn_unit(lds, QKV, LSE, in[16], b, g, h, x / ntile, x % ntile); }
        for (int u = c; u < 512; u += G) { const int qt = u & 31, hd = (u >> 5) & 3, b = u >> 7; att::xattn_unit(lds, XQ, MEMKV, b, hd, qt); }
    }
    SEAM(4);
    if (IN(5)) {
        { g8::OrdSloc S{(const char*)AG, (const char*)QT, G, c}; g8::EpiSloc E{SLOC};
          g8::gemm_phase<g8::EpiSloc, g8::OrdSloc, false>(lds, g8::Cfg{AG_PITCH, 1024, (size_t)128 * AG_PITCH * 2, 0}, S, E); }
        att::combine_rows(QKV, LSE, gw, NGW);
        constexpr int I_FIN = 16 * 176, I_FDN = 44 * 32;
        for (int it = gw; it < I_FIN + I_FDN; it += NGW) {
            if (it < I_FIN) prep::transpose_item(in[23], 1024, 5632, WFIN, 2816, in[22], scr, it, lane);
            else prep::transpose_item(in[24], 2816, 1024, WFDN, 0, nullptr, scr, it - I_FIN, lane); }
    }
    SEAM(5);
    if (IN(6)) { if (c < 16) ssm::carry_scan(c * 512 + tid, in[7], in[8], in[9], SLOC, AG); }
    SEAM(6);
    if (IN(7)) {
        g8::OrdY S{(const char*)AG, (const char*)LP, G, c}; g8::EpiY E{QKV + 768};
        g8::gemm_phase<g8::EpiY, g8::OrdY, true>(lds, g8::Cfg{AG_PITCH, LP_PITCH, (size_t)128 * AG_PITCH * 2, (size_t)128 * LP_PITCH * 2}, S, E);
    }
    SEAM(7);
    if (IN(8)) {
        g8::OrdDense S{(const char*)QKV, (const char*)WAU, 128, 4, 4, G, c, (size_t)256 * QKV_PITCH * 2, (size_t)256 * 256 * 2}; g8::EpiMerge<0> E{MERGED, MERGED};
        g8::gemm_phase<g8::EpiMerge<0>, g8::OrdDense, false>(lds, g8::Cfg{QKV_PITCH, 256, (size_t)128 * QKV_PITCH * 2, (size_t)128 * 256 * 2}, S, E);
    }
    SEAM(8);
    if (IN(9)) {
        g8::OrdDense S{(const char*)XQ, (const char*)WMU, 128, 4, 8, G, c, (size_t)256 * 512 * 2, (size_t)256 * 512 * 2}; g8::EpiMerge<1> E{GATE_M, MERGED};
        g8::gemm_phase<g8::EpiMerge<1>, g8::OrdDense, false>(lds, g8::Cfg{512, 512, (size_t)128 * 512 * 2, (size_t)128 * 512 * 2}, S, E);
    }
    SEAM(9);
    if (IN(10)) {
        g8::OrdDense S{(const char*)(QKV + 768), (const char*)WGLU, 128, 8, 8, G, c, (size_t)256 * QKV_PITCH * 2, (size_t)256 * 512 * 2}; g8::EpiMerge<2> E{GATE_S, MERGED};
        g8::gemm_phase<g8::EpiMerge<2>, g8::OrdDense, false>(lds, g8::Cfg{QKV_PITCH, 512, (size_t)128 * QKV_PITCH * 2, (size_t)128 * 512 * 2}, S, E);
    }
    SEAM(10);
    if (IN(11)) {
        g8::OrdDense S{(const char*)MERGED, (const char*)WOUT, 128, 4, 16, G, c, (size_t)256 * 1024 * 2, (size_t)256 * 1024 * 2}; g8::EpiResid E{OUT, OUT, XB, SS3, 1.0f};
        g8::gemm_phase<g8::EpiResid, g8::OrdDense, false>(lds, g8::Cfg{1024, 1024, (size_t)128 * 1024 * 2, (size_t)128 * 1024 * 2}, S, E);
    }
    SEAM(11);
    if (IN(12)) {
        g8::OrdDense S{(const char*)XB, (const char*)WFIN, 128, 22, 16, G, c, (size_t)256 * 1024 * 2, (size_t)256 * 1024 * 2}; g8::EpiSwiglu E{HB, SS3, 4};
        g8::gemm_phase<g8::EpiSwiglu, g8::OrdDense, false>(lds, g8::Cfg{1024, 1024, (size_t)128 * 1024 * 2, (size_t)128 * 1024 * 2}, S, E);
    }
    SEAM(12);
    if (IN(13)) {
        g8::OrdDense S{(const char*)HB, (const char*)WFDN, 128, 4, 44, G, c, (size_t)256 * D_FF * 2, (size_t)256 * D_FF * 2}; g8::EpiResid E{OUT, OUT, XB, SS4, 0.5f};
        g8::gemm_phase<g8::EpiResid, g8::OrdDense, false>(lds, g8::Cfg{D_FF, D_FF, (size_t)128 * D_FF * 2, (size_t)128 * D_FF * 2}, S, E);
    }
    SEAM(13);
    if (IN(14)) { for (int m = gw; m < MTOK; m += NGW) prep::final_row(OUT + (size_t)m * D_MODEL, SS4, m, in[25], lane); }
#undef IN
#undef SEAM
}

#ifndef MK_MULTI
#define MK_MULTI 1
#endif
extern "C" void kernel_launch(void* const* d_in, const int* in_sizes, int n_in, void* d_out, int out_size, void* d_ws, size_t ws_size, hipStream_t stream) {
    static int grid = 0;
    if (!grid) {
        if (n_in != 26 || in_sizes[0] != MTOK * D_MODEL || out_size != MTOK * D_MODEL || ws_size < WS_END) { fprintf(stderr, "kernel_launch: unexpected problem: n_in %d, in0 %d, out %d, ws %zu (need %zu)\n", n_in, n_in > 0 ? in_sizes[0] : -1, out_size, ws_size, (size_t)WS_END); grid = -1; return; }
        if (hipFuncSetAttribute((const void*)mega_fwd, hipFuncAttributeMaxDynamicSharedMemorySize, LDS_BYTES) != hipSuccess) { fprintf(stderr, "kernel_launch: hipFuncSetAttribute failed\n"); grid = -1; return; }
        int dev = 0, cus = 0, per_cu = 0;
        if (hipGetDevice(&dev) != hipSuccess || hipDeviceGetAttribute(&cus, hipDeviceAttributeMultiprocessorCount, dev) != hipSuccess) { fprintf(stderr, "kernel_launch: device query failed\n"); grid = -1; return; }
        if (hipOccupancyMaxActiveBlocksPerMultiprocessor(&per_cu, (const void*)mega_fwd, 512, LDS_BYTES) != hipSuccess || per_cu < 1) { fprintf(stderr, "kernel_launch: occupancy query says %d blocks per CU\n", per_cu); grid = -1; return; }
        grid = cus;
        if (grid > 256) grid = 256;
        if (grid < 32) { fprintf(stderr, "kernel_launch: %d CUs is too few\n", cus); grid = -1; return; }
    }
    if (grid < 0) return;
    (void)hipMemsetAsync((char*)d_ws + WS_CTL, 0, 64 * 1024, stream);
    Args a{};
    for (int i = 0; i < 26; ++i) a.in[i] = (const float*)d_in[i];
    a.out = (float*)d_out; a.ws = (unsigned char*)d_ws;
#if MK_MULTI
    for (int p = 0; p < NPHASE; ++p) { a.ph_lo = p; a.ph_hi = p + 1; hipLaunchKernelGGL(mega_fwd, dim3(grid), dim3(512), LDS_BYTES, stream, a); }
#else
    a.ph_lo = 0; a.ph_hi = NPHASE;
    void* kargs[] = {&a};
    hipError_t e = hipLaunchCooperativeKernel((const void*)mega_fwd, dim3(grid), dim3(512), kargs, LDS_BYTES, stream);
    if (e != hipSuccess) fprintf(stderr, "kernel_launch: cooperative launch failed: %s (grid %d)\n", hipGetErrorString(e), grid);
#endif
}
```

```cpp
#include <hip/hip_runtime.h>
#include <cstdio>
#include <cstdint>
#include <cmath>
#define MK_MULTI 0
#define LAS __attribute__((address_space(3)))
#define GAS __attribute__((address_space(1)))
typedef unsigned short bf16_t;
typedef short bf16x8 __attribute__((ext_vector_type(8)));
typedef short s16x4 __attribute__((ext_vector_type(4)));
typedef float f32x4 __attribute__((ext_vector_type(4)));
typedef float f32x2 __attribute__((ext_vector_type(2)));
typedef float f32x16 __attribute__((ext_vector_type(16)));
typedef unsigned u32x4 __attribute__((ext_vector_type(4)));
typedef unsigned u32x2 __attribute__((ext_vector_type(2)));

constexpr int D_MODEL = 1024, NBATCH = 4, SEQ = 8192, MTOK = NBATCH * SEQ;
constexpr int D_FF = 2816, IN_WIDTH = 6400, MEM_LEN = 256, MEMROWS = NBATCH * MEM_LEN;
constexpr float EPS = 1e-6f;
constexpr float LOG2E = 1.4426950408889634f;

__device__ __forceinline__ unsigned cvt_pk_bf16(float lo, float hi) { unsigned r; asm volatile("v_cvt_pk_bf16_f32 %0, %1, %2" : "=v"(r) : "v"(lo), "v"(hi)); return r; }
__device__ __forceinline__ float bf_lo(unsigned w) { return __uint_as_float(w << 16); }
__device__ __forceinline__ float bf_hi(unsigned w) { return __uint_as_float(w & 0xffff0000u); }
__device__ __forceinline__ float fast_sigmoid(float v) { return __builtin_amdgcn_rcpf(1.f + __builtin_amdgcn_exp2f(-v * LOG2E)); }
__device__ __forceinline__ float gelu_tanh_f(float v) { const float z = 0.7978845608028654f * (v + 0.044715f * v * v * v); return v * __builtin_amdgcn_rcpf(1.f + __builtin_amdgcn_exp2f(-2.f * LOG2E * z)); }
__device__ __forceinline__ float wave_sum(float v) {
#pragma unroll
    for (int o = 1; o < 64; o <<= 1) v += __shfl_xor(v, o);
    return v;
}

constexpr size_t KiB = 1024;
constexpr size_t WS_CTL = 0;
constexpr size_t WS_SS1 = 64 * KiB;
constexpr size_t WS_SS2 = WS_SS1 + 128 * KiB;
constexpr size_t WS_SS3 = WS_SS2 + 512 * KiB;
constexpr size_t WS_SS4 = WS_SS3 + 512 * KiB;
constexpr size_t WS_SSM = WS_SS4 + 512 * KiB;
constexpr size_t WS_MEMB = 1792 * KiB;
constexpr size_t WS_MEMKV = WS_MEMB + 2048 * KiB;
constexpr size_t WS_WIN = WS_MEMKV + 2048 * KiB;
constexpr size_t WS_WGLU = WS_WIN + 12800 * KiB;
constexpr size_t WS_WAU = WS_WGLU + 2048 * KiB;
constexpr size_t WS_WKV = WS_WAU + 512 * KiB;
constexpr size_t WS_WMU = WS_WKV + 2048 * KiB;
constexpr size_t WS_WOUT = WS_WMU + 1024 * KiB;
constexpr size_t WS_WFIN = WS_WOUT + 2048 * KiB;
constexpr size_t WS_WFDN = WS_WFIN + 11264 * KiB;
constexpr size_t WS_XB = WS_WFDN + 5632 * KiB;
constexpr size_t WS_LP = WS_XB;
constexpr size_t WS_QT = WS_LP + 24576 * KiB;
constexpr size_t WS_SLOC = WS_QT + 8192 * KiB;
constexpr size_t WS_LSE = WS_SLOC + 8192 * KiB;
constexpr size_t WS_BIG = WS_XB + 65536 * KiB;
constexpr size_t WS_H = WS_BIG;
constexpr size_t WS_QKV = WS_BIG;
constexpr size_t WS_XQ = WS_QKV + 147456 * KiB;
constexpr size_t WS_AG = WS_XQ + 32768 * KiB;
constexpr size_t WS_GATE = WS_AG + 36864 * KiB;
constexpr size_t WS_END = WS_GATE + 3 * 65536 * KiB;
static_assert(WS_SSM + 4 * KiB <= WS_MEMB, "ws map");
static_assert(WS_LSE + 1536 * KiB <= WS_BIG, "ws map");
static_assert(WS_END <= (size_t)512 * 1024 * KiB, "ws map exceeds 512 MiB");
constexpr int QKV_PITCH = 2304, AG_PITCH = 1152, LP_PITCH = 1536;
namespace g8 {
constexpr int BM = 256, BK = 64, HALF = 128, HTB = HALF * BK * 2, STAGE_BYTES = 8 * HTB;

__host__ __device__ __forceinline__ int lds_byte(int r, int c) { const int st = (r >> 4) * 2 + (c >> 5), rr = r & 15, cc = c & 31, ob = rr * 64 + cc * 2; return st * 1024 + (ob ^ (((ob >> 9) & 1) << 5)); }
__host__ __device__ __forceinline__ void stage_rc(int b, int& R, int& C) { const int st = b / 1024, sb = b % 1024, swz = sb ^ (((sb >> 9) & 1) << 5); R = (st >> 1) * 16 + swz / 64; C = (st & 1) * 32 + (swz % 64) / 2; }
__host__ __device__ __forceinline__ int perm32(int rho) { const int n = rho >> 4, i = rho & 15; return 8 * (i >> 2) + 4 * n + (i & 3); }

struct Unit { const char* A; const char* B; int pm, pn, aux, nt, nt1, jumpA, jumpB; };
struct Cfg { int lda, ldb; size_t hstepA, hstepB; };

__device__ __forceinline__ void decode_tile(int L, int nM, int nN, int& pm, int& pn) {
    const int nwg = nM * nN; int wgid = L;
    { const int q = nwg / 8, r = nwg % 8, xcd = wgid % 8, off = wgid / 8; wgid = (xcd < r ? xcd * (q + 1) : r * (q + 1) + (xcd - r) * q) + off; }
    const int nig = 8 * nN, gid = wgid / nig, fm = gid * 8, gsz = (nM - fm) < 8 ? (nM - fm) : 8;
    pm = fm + ((wgid % nig) % gsz); pn = (wgid % nig) / gsz;
}

template <class Epi, class Sched, bool JUMP>
__device__ __forceinline__ void gemm_phase(LAS unsigned char* lds, const Cfg cfg, const Sched& S, const Epi& E) {
    const int tid = threadIdx.x, wid = __builtin_amdgcn_readfirstlane(tid >> 6), lane = tid & 63, wr = wid >> 2, wc = wid & 3, fr = lane & 15, fq = lane >> 4;
    unsigned voffA[2], voffB[2];
#pragma unroll
    for (int i = 0; i < 2; ++i) { int R, C; stage_rc(tid * 16 + i * 8192, R, C); const int Rb = Epi::PERM ? ((R & ~31) + perm32(R & 31)) : R;
        voffA[i] = (unsigned)(R * cfg.lda + C) * 2u; voffB[i] = (unsigned)(Rb * cfg.ldb + C) * 2u; }
    const size_t kstep = (size_t)(BK * 2);
    const size_t hsA = cfg.hstepA, hsB = cfg.hstepB;
    const unsigned ldsw = (unsigned)wid * 1024u;
    const int aoff = lds_byte(wr * 64 + fr, fq * 8), boff = lds_byte(wc * 32 + fr, fq * 8);
#define G8_SA(b, h) (((b) * 2 + (h)) * HTB)
#define G8_SB(b, h) ((4 + (b) * 2 + (h)) * HTB)
#define G8_STAGE(bufoff, gbase, voff) do { _Pragma("unroll") for (int _i = 0; _i < 2; ++_i) \
        __builtin_amdgcn_global_load_lds((const unsigned*)((const char*)(gbase) + (voff)[_i]), (LAS unsigned*)(lds + (bufoff) + ldsw + _i * 8192), 16, 0, 0); } while (0)
#define G8_LDA(dst, b, h) do { _Pragma("unroll") for (int m = 0; m < 4; ++m) _Pragma("unroll") for (int k = 0; k < 2; ++k) dst[m][k] = *(const LAS bf16x8*)(lds + G8_SA(b, h) + aoff + m * 2048 + k * 1024); } while (0)
#define G8_LDB(dst, b, h) do { _Pragma("unroll") for (int n = 0; n < 2; ++n) _Pragma("unroll") for (int k = 0; k < 2; ++k) dst[n][k] = *(const LAS bf16x8*)(lds + G8_SB(b, h) + boff + n * 2048 + k * 1024); } while (0)
#define G8_MMA(ai, bj, At, Bt) do { __builtin_amdgcn_s_setprio(1); _Pragma("unroll") for (int m = 0; m < 4; ++m) _Pragma("unroll") for (int n = 0; n < 2; ++n) _Pragma("unroll") for (int k = 0; k < 2; ++k) \
        acc[ai][bj][m][n] = __builtin_amdgcn_mfma_f32_16x16x32_bf16(Bt[n][k], At[m][k], acc[ai][bj][m][n], 0, 0, 0); __builtin_amdgcn_s_setprio(0); } while (0)
#define G8_WAIT_V(n) asm volatile("s_waitcnt vmcnt(" #n ")" ::: "memory")
#define G8_WAIT_L(n) asm volatile("s_waitcnt lgkmcnt(" #n ")" ::: "memory")
#define G8_BAR __builtin_amdgcn_s_barrier()
#define G8_SCHED __builtin_amdgcn_sched_barrier(0)
#define G8_KA(u, t) ((size_t)(t) * kstep + ((JUMP && (t) >= (u).nt1) ? (size_t)(long)(u).jumpA : (size_t)0))
#define G8_KB(u, t) ((size_t)(t) * kstep + ((JUMP && (t) >= (u).nt1) ? (size_t)(long)(u).jumpB : (size_t)0))
    Unit cur, nxt; int ui = 0;
    if (!S.next(0, cur)) return;
    f32x4 acc[2][2][4][2];
#pragma unroll
    for (int a = 0; a < 2; ++a)
#pragma unroll
        for (int b = 0; b < 2; ++b)
#pragma unroll
            for (int m = 0; m < 4; ++m)
#pragma unroll
                for (int n = 0; n < 2; ++n) acc[a][b][m][n] = (f32x4){0.f, 0.f, 0.f, 0.f};
    bf16x8 At[4][2], B0[2][2], B1[2][2];
    const char* cA = cur.A; const char* cB = cur.B;
    G8_STAGE(G8_SB(0, 0), cB, voffB); G8_STAGE(G8_SB(0, 1), cB + hsB, voffB); G8_STAGE(G8_SA(0, 0), cA, voffA); G8_STAGE(G8_SA(0, 1), cA + hsA, voffA);
    if (wr == 1) G8_BAR;
    G8_WAIT_V(2); G8_BAR;
    G8_STAGE(G8_SB(1, 0), cB + kstep, voffB); G8_STAGE(G8_SA(1, 0), cA + kstep, voffA); G8_STAGE(G8_SB(1, 1), cB + hsB + kstep, voffB);
    G8_WAIT_V(6); G8_BAR;
    for (;;) {
        const bool has_next = S.next(ui + 1, nxt);
        const char* nA = has_next ? nxt.A : cA; const char* nB = has_next ? nxt.B : cB;
        const int nt = cur.nt;
        for (int t = 0; t < nt; t += 2) {
            const bool last = (t == nt - 2);
            const char* a1 = cA + G8_KA(cur, t + 1);
            const char* a2 = last ? nA : cA + G8_KA(cur, t + 2); const char* b2 = last ? nB : cB + G8_KB(cur, t + 2);
            const char* a3 = last ? nA + kstep : cA + G8_KA(cur, t + 3); const char* b3 = last ? nB + kstep : cB + G8_KB(cur, t + 3);
            G8_LDB(B0, 0, 0); G8_LDB(B1, 0, 1); G8_SCHED; G8_LDA(At, 0, 0); G8_STAGE(G8_SA(1, 1), a1 + hsA, voffA);
            G8_WAIT_V(8); G8_WAIT_L(0); G8_BAR; G8_MMA(0, 0, At, B0); G8_MMA(0, 1, At, B1); G8_BAR; G8_SCHED;
            G8_LDA(At, 0, 1); G8_STAGE(G8_SB(0, 0), b2, voffB); G8_STAGE(G8_SB(0, 1), b2 + hsB, voffB); G8_STAGE(G8_SA(0, 0), a2, voffA);
            G8_WAIT_V(8); G8_WAIT_L(0); G8_BAR; G8_MMA(1, 0, At, B0); G8_MMA(1, 1, At, B1); G8_BAR; G8_SCHED;
            G8_LDB(B0, 1, 0); G8_LDB(B1, 1, 1); G8_SCHED; G8_LDA(At, 1, 0); G8_STAGE(G8_SA(0, 1), a2 + hsA, voffA);
            G8_WAIT_V(8); G8_WAIT_L(0); G8_BAR; G8_MMA(0, 0, At, B0); G8_MMA(0, 1, At, B1); G8_BAR; G8_SCHED;
            G8_LDA(At, 1, 1); G8_STAGE(G8_SB(1, 0), b3, voffB); G8_STAGE(G8_SB(1, 1), b3 + hsB, voffB); G8_STAGE(G8_SA(1, 0), a3, voffA);
            G8_WAIT_V(8); G8_WAIT_L(0); G8_BAR; G8_MMA(1, 0, At, B0); G8_MMA(1, 1, At, B1); G8_BAR; G8_SCHED;
        }
        if (wr == 0) G8_BAR;
        E(acc, cur, wr, wc, fr, fq, lds);
        if (!has_next) break;
#pragma unroll
        for (int a = 0; a < 2; ++a)
#pragma unroll
            for (int b = 0; b < 2; ++b)
#pragma unroll
                for (int m = 0; m < 4; ++m)
#pragma unroll
                    for (int n = 0; n < 2; ++n) acc[a][b][m][n] = (f32x4){0.f, 0.f, 0.f, 0.f};
        cur = nxt; cA = nA; cB = nB; ++ui;
        if (wr == 1) G8_BAR;
    }
    G8_WAIT_V(0);
    G8_BAR;
#undef G8_SA
#undef G8_SB
#undef G8_STAGE
#undef G8_LDA
#undef G8_LDB
#undef G8_MMA
#undef G8_WAIT_V
#undef G8_WAIT_L
#undef G8_BAR
#undef G8_SCHED
#undef G8_KA
#undef G8_KB
}
}
namespace g8 {
constexpr int EPI_SCR = STAGE_BYTES;

__device__ __forceinline__ float row_rstd(const float* ss, int nparts, int stride, int row) {
    float s = ss[row];
    for (int i = 1; i < nparts; ++i) s += ss[(size_t)i * stride + row];
    return rsqrtf(s * (1.f / D_MODEL) + EPS);
}

struct EpiSwiglu {
    static constexpr bool PERM = true;
    bf16_t* H; const float* ss; int nparts;
    __device__ __forceinline__ void operator()(const f32x4 (&acc)[2][2][4][2], const Unit& u, int wr, int wc, int fr, int fq, LAS unsigned char*) const {
#pragma unroll
        for (int ai = 0; ai < 2; ++ai)
#pragma unroll
            for (int m = 0; m < 4; ++m) {
                const int row = u.pm * BM + ai * HALF + wr * 64 + m * 16 + fr;
                const float r = row_rstd(ss, nparts, MTOK, row);
                float hv[8];
#pragma unroll
                for (int n = 0; n < 2; ++n)
#pragma unroll
                    for (int j = 0; j < 4; ++j) { const float a = acc[ai][0][m][n][j] * r, b = acc[ai][1][m][n][j] * r; hv[n * 4 + j] = a * fast_sigmoid(a) * b; }
                u32x4 w; w.x = cvt_pk_bf16(hv[0], hv[1]); w.y = cvt_pk_bf16(hv[2], hv[3]); w.z = cvt_pk_bf16(hv[4], hv[5]); w.w = cvt_pk_bf16(hv[6], hv[7]);
                *(u32x4*)(H + (size_t)row * D_FF + u.pn * 128 + wc * 32 + fq * 8) = w;
            }
    }
};

struct EpiResid {
    static constexpr bool PERM = false;
    const float* xres; float* xout; bf16_t* xb; float* ssout; float alpha;
    __device__ __forceinline__ void operator()(const f32x4 (&acc)[2][2][4][2], const Unit& u, int wr, int wc, int fr, int fq, LAS unsigned char* lds) const {
        LAS float* scr = (LAS float*)(lds + EPI_SCR);
#pragma unroll
        for (int ai = 0; ai < 2; ++ai)
#pragma unroll
            for (int m = 0; m < 4; ++m) {
                const int lrow = ai * HALF + wr * 64 + m * 16 + fr; const size_t row = (size_t)u.pm * BM + lrow;
                float sq = 0.f;
#pragma unroll
                for (int bj = 0; bj < 2; ++bj)
#pragma unroll
                    for (int n = 0; n < 2; ++n) {
                        const size_t off = row * D_MODEL + u.pn * BM + bj * HALF + wc * 32 + n * 16 + fq * 4;
                        const f32x4 xr = *(const f32x4*)(xres + off); f32x4 o = xr + acc[ai][bj][m][n] * alpha;
                        *(f32x4*)(xout + off) = o; sq += (o[0] * o[0] + o[1] * o[1]) + (o[2] * o[2] + o[3] * o[3]);
                        u32x2 w; w.x = cvt_pk_bf16(o[0], o[1]); w.y = cvt_pk_bf16(o[2], o[3]); *(u32x2*)(xb + off) = w;
                    }
                sq += __shfl_xor(sq, 16); sq += __shfl_xor(sq, 32);
                if (fq == 0) scr[lrow * 4 + wc] = sq;
            }
        asm volatile("s_waitcnt lgkmcnt(0)" ::: "memory"); __builtin_amdgcn_s_barrier(); asm volatile("" ::: "memory");
        if (threadIdx.x < 256) { const int lrow = threadIdx.x; const f32x4 p = *(const LAS f32x4*)(scr + lrow * 4);
            ssout[(size_t)u.pn * MTOK + (size_t)u.pm * BM + lrow] = (p[0] + p[1]) + (p[2] + p[3]); }
        asm volatile("s_waitcnt lgkmcnt(0)" ::: "memory"); __builtin_amdgcn_s_barrier(); asm volatile("" ::: "memory");
    }
};

struct EpiProj {
    static constexpr bool PERM = true;
    const float* ss2; const float* ssm; bf16_t *AG, *QKV, *XQ, *GATE, *MEMKV;
    __device__ __forceinline__ void operator()(const f32x4 (&acc)[2][2][4][2], const Unit& u, int wr, int wc, int fr, int fq, LAS unsigned char*) const {
        const int pn = u.pn; const bool is_mem = (u.aux != 0);
        int kind; bf16_t* dst; int pitch; float scale = 1.f;
        if (is_mem) { kind = 0; dst = MEMKV + pn * 256; pitch = 1024; }
        else if (pn < 2) { kind = 2; dst = AG; pitch = 0; }
        else if (pn < 11) { kind = 0; dst = QKV + (pn - 2) * 256; pitch = QKV_PITCH; if (pn < 5) scale = 0.125f * LOG2E; }
        else if (pn < 13) { kind = 0; dst = XQ + (pn - 11) * 256; pitch = 512; scale = 0.08838834764831845f * LOG2E; }
        else { kind = 1; const int gi = (pn - 13) >> 2; dst = GATE + (size_t)gi * MTOK * D_MODEL + ((pn - 13) & 3) * 256; pitch = 1024; }
#pragma unroll
        for (int ai = 0; ai < 2; ++ai)
#pragma unroll
            for (int m = 0; m < 4; ++m) {
                const int row = u.pm * BM + ai * HALF + wr * 64 + m * 16 + fr;
                const float r = (is_mem ? rsqrtf(ssm[row] * (1.f / D_MODEL) + EPS) : row_rstd(ss2, 4, MTOK, row)) * scale;
#pragma unroll
                for (int bj = 0; bj < 2; ++bj) {
                    float v[8];
#pragma unroll
                    for (int n = 0; n < 2; ++n)
#pragma unroll
                        for (int j = 0; j < 4; ++j) { float x = acc[ai][bj][m][n][j] * r; if (kind == 1) x = fast_sigmoid(x); v[n * 4 + j] = x; }
                    u32x4 w; w.x = cvt_pk_bf16(v[0], v[1]); w.y = cvt_pk_bf16(v[2], v[3]); w.z = cvt_pk_bf16(v[4], v[5]); w.w = cvt_pk_bf16(v[6], v[7]);
                    const int col = bj * HALF + wc * 32 + fq * 8;
                    bf16_t* p;
                    if (kind == 2) { const int ch = pn * 256 + col, g = ch >> 4, h0 = ch & 15; const int b = row >> 13, l = row & 8191, c = l >> 6, t = l & 63;
                        p = AG + ((size_t)(g * 512 + b * 128 + c) * AG_PITCH + t * 16 + h0); }
                    else p = dst + (size_t)row * pitch + col;
                    *(u32x4*)p = w;
                }
            }
    }
};

struct EpiSloc {
    static constexpr bool PERM = false;
    float* SLOC;
    __device__ __forceinline__ void operator()(const f32x4 (&acc)[2][2][4][2], const Unit& u, int wr, int wc, int fr, int fq, LAS unsigned char*) const {
#pragma unroll
        for (int ai = 0; ai < 2; ++ai)
#pragma unroll
            for (int m = 0; m < 4; ++m) {
                const int row = u.pm * BM + ai * HALF + wr * 64 + m * 16 + fr;
#pragma unroll
                for (int n = 0; n < 2; ++n) *(f32x4*)(SLOC + (size_t)row * 128 + wc * 32 + n * 16 + fq * 4) = acc[ai][0][m][n];
            }
    }
};

struct EpiY {
    static constexpr bool PERM = true;
    bf16_t* Y;
    __device__ __forceinline__ void operator()(const f32x4 (&acc)[2][2][4][2], const Unit& u, int wr, int wc, int fr, int fq, LAS unsigned char*) const {
        const int g = u.pm >> 1, rt = u.pm & 1, j = u.pn;
#pragma unroll
        for (int ai = 0; ai < 2; ++ai)
#pragma unroll
            for (int m = 0; m < 4; ++m) {
                const int r = rt * 256 + ai * HALF + wr * 64 + m * 16 + fr; const int b = r >> 7, c = r & 127;
#pragma unroll
                for (int bj = 0; bj < 2; ++bj) {
                    const int col = bj * HALF + wc * 32 + fq * 8, tl = col >> 4, h0 = col & 15; const int tok = b * SEQ + c * 64 + j * 16 + tl;
                    float v[8];
#pragma unroll
                    for (int n = 0; n < 2; ++n)
#pragma unroll
                        for (int q = 0; q < 4; ++q) v[n * 4 + q] = gelu_tanh_f(acc[ai][bj][m][n][q]);
                    u32x4 w; w.x = cvt_pk_bf16(v[0], v[1]); w.y = cvt_pk_bf16(v[2], v[3]); w.z = cvt_pk_bf16(v[4], v[5]); w.w = cvt_pk_bf16(v[6], v[7]);
                    *(u32x4*)(Y + (size_t)tok * QKV_PITCH + g * 16 + h0) = w;
                }
            }
    }
};

template <int MODE> struct EpiMerge {
    static constexpr bool PERM = true;
    const bf16_t* gate; bf16_t* merged;
    __device__ __forceinline__ void operator()(const f32x4 (&acc)[2][2][4][2], const Unit& u, int wr, int wc, int fr, int fq, LAS unsigned char*) const {
#pragma unroll
        for (int ai = 0; ai < 2; ++ai)
#pragma unroll
            for (int m = 0; m < 4; ++m) {
                const size_t row = (size_t)u.pm * BM + ai * HALF + wr * 64 + m * 16 + fr;
#pragma unroll
                for (int bj = 0; bj < (MODE == 2 ? 1 : 2); ++bj) {
                    const size_t off = row * D_MODEL + (MODE == 2 ? u.pn * 128 : u.pn * BM + bj * HALF) + wc * 32 + fq * 8;
                    float v[8];
#pragma unroll
                    for (int n = 0; n < 2; ++n)
#pragma unroll
                        for (int q = 0; q < 4; ++q) v[n * 4 + q] = (MODE == 2) ? acc[ai][0][m][n][q] * fast_sigmoid(acc[ai][1][m][n][q]) : acc[ai][bj][m][n][q];
                    const u32x4 gw = *(const u32x4*)(gate + off);
                    float o[8];
#pragma unroll
                    for (int q = 0; q < 4; ++q) { o[2 * q] = bf_lo(gw[q]) * v[2 * q]; o[2 * q + 1] = bf_hi(gw[q]) * v[2 * q + 1]; }
                    if (MODE != 0) { const u32x4 mw = *(const u32x4*)(merged + off);
#pragma unroll
                        for (int q = 0; q < 4; ++q) { o[2 * q] += bf_lo(mw[q]); o[2 * q + 1] += bf_hi(mw[q]); } }
                    u32x4 w; w.x = cvt_pk_bf16(o[0], o[1]); w.y = cvt_pk_bf16(o[2], o[3]); w.z = cvt_pk_bf16(o[4], o[5]); w.w = cvt_pk_bf16(o[6], o[7]);
                    *(u32x4*)(merged + off) = w;
                }
            }
    }
};

struct OrdDense {
    const char* A; const char* B; int nM, nN, nt, G, c; size_t tstepA, tstepB;
    __device__ __forceinline__ bool next(int i, Unit& u) const {
        const long L = (long)i * G + c; if (L >= (long)nM * nN) return false;
        decode_tile((int)L, nM, nN, u.pm, u.pn); u.A = A + (size_t)u.pm * tstepA; u.B = B + (size_t)u.pn * tstepB; u.aux = 0; u.nt = nt; u.nt1 = nt; u.jumpA = 0; u.jumpB = 0; return true;
    }
};
struct OrdProj {
    const char *A, *B, *Am, *Bm; int G, c;
    __device__ __forceinline__ bool next(int i, Unit& u) const {
        const long L = (long)i * G + c; u.nt = 16; u.nt1 = 16; u.jumpA = 0; u.jumpB = 0;
        if (L < 3200) { decode_tile((int)L, 128, 25, u.pm, u.pn); u.A = A + (size_t)u.pm * (256 * 1024 * 2); u.B = B + (size_t)u.pn * (256 * 1024 * 2); u.aux = 0; return true; }
        if (L < 3216) { const int x = (int)L - 3200; u.pm = x >> 2; u.pn = x & 3; u.A = Am + (size_t)u.pm * (256 * 1024 * 2); u.B = Bm + (size_t)u.pn * (256 * 1024 * 2); u.aux = 1; return true; }
        return false;
    }
};
struct OrdSloc {
    const char *AG, *QT; int G, c;
    __device__ __forceinline__ bool next(int i, Unit& u) const {
        const long L = (long)i * G + c; if (L >= 64) return false;
        u.pm = (int)L; u.pn = 0; u.A = AG + (size_t)u.pm * (256 * AG_PITCH * 2); u.B = QT + (size_t)(u.pm >> 1) * (128 * 1024 * 2); u.aux = 0; u.nt = 16; u.nt1 = 16; u.jumpA = 0; u.jumpB = 0; return true;
    }
};
struct OrdY {
    const char *AG, *LP; int G, c;
    __device__ __forceinline__ bool next(int i, Unit& u) const {
        const long L = (long)i * G + c; if (L >= 256) return false;
        const int j = 3 - (int)(L >> 6), pm = (int)(L & 63);
        u.pm = pm; u.pn = j; u.aux = 0; u.A = AG + (size_t)pm * (256 * AG_PITCH * 2); u.B = LP + (size_t)(pm >> 1) * (256 * LP_PITCH * 2) + (size_t)(48 - 16 * j) * 16 * 2;
        u.nt1 = 4 * (j + 1); u.nt = u.nt1 + 2; u.jumpA = (1024 - 256 * (j + 1)) * 2; u.jumpB = (1024 + 128 * j - ((48 - 16 * j) * 16 + 256 * (j + 1))) * 2; return true;
    }
};
}
namespace att {
__device__ __forceinline__ int tid_opaque() { int t = threadIdx.x; asm volatile("" : "+v"(t)); return t; }
__device__ __forceinline__ int crow(int r, int hi) { return (r & 3) + 8 * (r >> 2) + 4 * hi; }
__device__ __forceinline__ s16x4 vtr(const LAS char* p) { typedef short v4i16_t __attribute__((ext_vector_type(4))); return __builtin_bit_cast(s16x4, __builtin_amdgcn_ds_read_tr16_b64_v4i16((LAS v4i16_t*)p)); }

template <int D> __device__ __forceinline__ f32x16 qk_tile(const LAS char* Kl, int krow, const bf16x8 (&qf)[D / 16], int hh) {
    const LAS char* kp = Kl + krow * (D * 2); const int sw = krow & 7; f32x16 s = {};
#pragma unroll
    for (int d0 = 0; d0 < D / 16; ++d0) { const bf16x8 kf = *(const LAS bf16x8*)(kp + (((2 * d0 + hh) ^ sw) << 4)); s = __builtin_amdgcn_mfma_f32_32x32x16_bf16(kf, qf[d0], s, 0, 0, 0); }
    return s;
}
template <int D> __device__ __forceinline__ void pv_tile(f32x16 (&o)[D / 32], const LAS char* vb, bf16x8 pb0, bf16x8 pb1) {
    constexpr int RB = D * 2;
#pragma unroll
    for (int db = 0; db < D / 32; ++db) {
        const s16x4 a0 = vtr(vb + db * 64), a1 = vtr(vb + db * 64 + 8 * RB), a2 = vtr(vb + db * 64 + 16 * RB), a3 = vtr(vb + db * 64 + 24 * RB);
        const bf16x8 v0 = (bf16x8){a0[0], a0[1], a0[2], a0[3], a1[0], a1[1], a1[2], a1[3]}, v1 = (bf16x8){a2[0], a2[1], a2[2], a2[3], a3[0], a3[1], a3[2], a3[3]};
        o[db] = __builtin_amdgcn_mfma_f32_32x32x16_bf16(v0, pb0, o[db], 0, 0, 0);
        o[db] = __builtin_amdgcn_mfma_f32_32x32x16_bf16(v1, pb1, o[db], 0, 0, 0);
    }
}
__device__ __forceinline__ void pack_p(const f32x16& p, bf16x8& pb0, bf16x8& pb1) {
    u32x4 w0, w1;
    w0.x = cvt_pk_bf16(p[0], p[1]); w0.y = cvt_pk_bf16(p[2], p[3]); w0.z = cvt_pk_bf16(p[4], p[5]); w0.w = cvt_pk_bf16(p[6], p[7]);
    w1.x = cvt_pk_bf16(p[8], p[9]); w1.y = cvt_pk_bf16(p[10], p[11]); w1.z = cvt_pk_bf16(p[12], p[13]); w1.w = cvt_pk_bf16(p[14], p[15]);
    pb0 = __builtin_bit_cast(bf16x8, w0); pb1 = __builtin_bit_cast(bf16x8, w1);
}
__device__ __forceinline__ float max16(const f32x16& s) {
    float a = fmaxf(fmaxf(s[0], s[1]), fmaxf(s[2], s[3])), b = fmaxf(fmaxf(s[4], s[5]), fmaxf(s[6], s[7])), c = fmaxf(fmaxf(s[8], s[9]), fmaxf(s[10], s[11])), d = fmaxf(fmaxf(s[12], s[13]), fmaxf(s[14], s[15]));
    return fmaxf(fmaxf(a, b), fmaxf(c, d));
}

__device__ __forceinline__ void dattn_wave(int lane, const LAS char* Kl, const LAS char* Vl, int krow0, const bf16x8 (&qf)[4], const LAS float* biasL, int first_ok, f32x16 (&o)[2], float& m_out, float& l_out) {
    const int r = lane & 31, hh = lane >> 5;
    f32x16 s[5];
#pragma unroll
    for (int kt = 0; kt < 5; ++kt) s[kt] = qk_tile<64>(Kl, krow0 + 32 * kt + r, qf, hh);
    float m = -INFINITY;
#pragma unroll
    for (int kt = 0; kt < 5; ++kt) {
        const bool tile_ok = kt >= first_ok;
#pragma unroll
        for (int rg = 0; rg < 16; ++rg) { const int kl = crow(rg, hh), j = r + 128 - 32 * kt - kl;
            bool ok = tile_ok; if (kt == 0) ok = ok && (kl >= r); if (kt == 4) ok = ok && (kl <= r);
            const float v = ok ? s[kt][rg] + biasL[(kt == 0) ? min(j, 128) : ((kt == 4) ? max(j, 0) : j)] : -INFINITY; s[kt][rg] = v; }
        m = fmaxf(m, max16(s[kt]));
    }
    m = fmaxf(m, __shfl_xor(m, 32));
    float l = 0.f;
    o[0] = f32x16{}; o[1] = f32x16{};
    const int gi = lane >> 4, li = lane & 15;
    const LAS char* vb0 = Vl + (krow0 + 4 * (gi >> 1) + (li >> 2)) * 128 + (16 * (gi & 1) + 4 * (li & 3)) * 2;
#pragma unroll
    for (int kt = 0; kt < 5; ++kt) {
        float ps = 0.f;
#pragma unroll
        for (int rg = 0; rg < 16; ++rg) { s[kt][rg] = __builtin_amdgcn_exp2f(s[kt][rg] - m); ps += s[kt][rg]; }
        l += ps;
        bf16x8 pb0, pb1; pack_p(s[kt], pb0, pb1);
        pv_tile<64>(o, vb0 + kt * 32 * 128, pb0, pb1);
    }
    l += __shfl_xor(l, 32);
    m_out = m; l_out = l;
}

__device__ __forceinline__ void xattn_wave(int lane, const LAS char* Kl, const LAS char* Vl, const bf16x8 (&qf)[8], f32x16 (&o)[4], float& l_out) {
    const int r = lane & 31, hh = lane >> 5;
    const int gi = lane >> 4, li = lane & 15;
    const LAS char* vb0 = Vl + (4 * (gi >> 1) + (li >> 2)) * 256 + (16 * (gi & 1) + 4 * (li & 3)) * 2;
    float m = 0.f, l = 0.f;
#pragma unroll
    for (int db = 0; db < 4; ++db) o[db] = f32x16{};
#pragma unroll
    for (int ck = 0; ck < 4; ++ck) {
        f32x16 s[2];
#pragma unroll
        for (int t = 0; t < 2; ++t) s[t] = qk_tile<128>(Kl, 32 * (2 * ck + t) + r, qf, hh);
        float tm = fmaxf(max16(s[0]), max16(s[1]));
        tm = fmaxf(tm, __shfl_xor(tm, 32));
        if (ck == 0) m = tm;
        else { const float mn = fmaxf(m, tm), sc = __builtin_amdgcn_exp2f(m - mn); m = mn; l *= sc;
#pragma unroll
            for (int db = 0; db < 4; ++db) o[db] = o[db] * sc; }
#pragma unroll
        for (int t = 0; t < 2; ++t) {
            float ps = 0.f;
#pragma unroll
            for (int rg = 0; rg < 16; ++rg) { s[t][rg] = __builtin_amdgcn_exp2f(s[t][rg] - m); ps += s[t][rg]; }
            l += ps;
            bf16x8 pb0, pb1; pack_p(s[t], pb0, pb1);
            pv_tile<128>(o, vb0 + (2 * ck + t) * 32 * 256, pb0, pb1);
        }
    }
    l += __shfl_xor(l, 32);
    l_out = l;
}

template <int D> __device__ __forceinline__ void store_o(int hh, bf16_t* orow, const f32x16 (&o)[D / 32], float inv_l) {
#pragma unroll
    for (int db = 0; db < D / 32; ++db)
#pragma unroll
        for (int q4 = 0; q4 < 4; ++q4) { u32x2 w; w.x = cvt_pk_bf16(o[db][4 * q4] * inv_l, o[db][4 * q4 + 1] * inv_l); w.y = cvt_pk_bf16(o[db][4 * q4 + 2] * inv_l, o[db][4 * q4 + 3] * inv_l);
            *(u32x2*)(orow + 32 * db + 8 * q4 + 4 * hh) = w; }
}

__device__ const unsigned char BUCKETS[3][129] = {
{0,1,2,3,4,5,6,7,8,9,10,11,12,13,14,15,16,16,16,16,16,16,17,17,17,17,17,17,17,17,18,18,18,18,18,18,18,18,18,18,19,19,19,19,19,19,19,19,19,19,19,19,19,19,20,20,20,20,20,20,20,20,20,20,20,20,20,20,20,20,20,20,20,21,21,21,21,21,21,21,21,21,21,21,21,21,21,21,21,21,21,21,21,21,21,21,21,21,21,22,22,22,22,22,22,22,22,22,22,22,22,22,22,22,22,22,22,22,22,22,22,22,22,22,22,22,22,22,22},
{0,4,8,12,16,16,17,17,18,18,19,19,19,19,20,20,20,20,20,21,21,21,21,21,21,22,22,22,22,22,22,22,22,22,23,23,23,23,23,23,23,23,23,23,23,23,24,24,24,24,24,24,24,24,24,24,24,24,24,24,24,24,25,25,25,25,25,25,25,25,25,25,25,25,25,25,25,25,25,25,25,25,25,26,26,26,26,26,26,26,26,26,26,26,26,26,26,26,26,26,26,26,26,26,26,26,26,26,26,26,26,26,26,27,27,27,27,27,27,27,27,27,27,27,27,27,27,27,27},
{0,16,18,19,20,21,21,22,22,23,23,23,24,24,24,24,25,25,25,25,25,26,26,26,26,26,26,26,26,27,27,27,27,27,27,27,27,27,27,28,28,28,28,28,28,28,28,28,28,28,28,28,29,29,29,29,29,29,29,29,29,29,29,29,29,29,29,29,29,29,30,30,30,30,30,30,30,30,30,30,30,30,30,30,30,30,30,30,30,30,30,30,30,30,30,31,31,31,31,31,31,31,31,31,31,31,31,31,31,31,31,31,31,31,31,31,31,31,31,31,31,31,31,31,31,31,31,31,31}};

constexpr int LDS_K = 0, LDS_V = 65536, LDS_BIAS = 131072 + 4096;

__device__ __forceinline__ void dattn_unit(LAS unsigned char* lds, bf16_t* QKV, float* LSE, const float* rel, int b, int g, int h, int rs, int qt) {
    const int tid = tid_opaque(), lane = tid & 63, wid = __builtin_amdgcn_readfirstlane(tid >> 6), r = lane & 31, hh = lane >> 5;
    const int dil = (g == 0) ? 1 : (g == 1 ? 4 : 16);
    LAS char* Kl = (LAS char*)lds + LDS_K; LAS char* Vl = (LAS char*)lds + LDS_V; LAS float* biasL = (LAS float*)(lds + LDS_BIAS);
    const int nk0 = 256 * qt - 128;
    const size_t hcol = (size_t)g * 256 + h * 64;
    u32x4 kv[6], vv[6];
#pragma unroll
    for (int i = 0; i < 6; ++i) { const int e = tid + 512 * i, row = e >> 3, ch = e & 7; const int nk = nk0 + row;
        kv[i] = (u32x4){0u, 0u, 0u, 0u}; vv[i] = (u32x4){0u, 0u, 0u, 0u};
        if (nk >= 0) { const size_t tok = (size_t)b * SEQ + rs + (size_t)dil * nk; const bf16_t* src = QKV + tok * QKV_PITCH + hcol + ch * 8; kv[i] = *(const u32x4*)(src + 768); vv[i] = *(const u32x4*)(src + 1536); } }
    const int nq = 256 * qt + 32 * wid + r; const size_t qtok = (size_t)b * SEQ + rs + (size_t)dil * nq; bf16_t* qrow = QKV + qtok * QKV_PITCH + hcol;
    bf16x8 qf[4];
#pragma unroll
    for (int s = 0; s < 4; ++s) qf[s] = *(const bf16x8*)(qrow + 16 * s + 8 * hh);
    const float bv = (tid < 129) ? rel[(int)BUCKETS[g][tid] * 12 + g * 4 + h] * LOG2E : 0.f;
#pragma unroll
    for (int i = 0; i < 6; ++i) { const int e = tid + 512 * i, row = e >> 3, ch = e & 7;
        *(LAS u32x4*)(Kl + row * 128 + ((ch ^ (row & 7)) << 4)) = kv[i]; *(LAS u32x4*)(Vl + row * 128 + (ch << 4)) = vv[i]; }
    if (tid < 129) biasL[tid] = bv;
    __syncthreads();
    f32x16 o[2]; float m, l;
    dattn_wave(lane, Kl, Vl, 32 * wid, qf, biasL, (qt == 0) ? 4 - wid : 0, o, m, l);
    store_o<64>(hh, qrow, o, __builtin_amdgcn_rcpf(l));
    if (hh == 0) LSE[qtok * 12 + g * 4 + h] = m + __builtin_amdgcn_logf(l);
    __syncthreads();
}

__device__ __forceinline__ void xattn_units(LAS unsigned char* lds, bf16_t* XQ, const bf16_t* MEMKV, int b, int hd, int qt0, int nq) {
    const int tid = tid_opaque(), lane = tid & 63, wid = __builtin_amdgcn_readfirstlane(tid >> 6), r = lane & 31, hh = lane >> 5;
    LAS char* Kl = (LAS char*)lds + LDS_K; LAS char* Vl = (LAS char*)lds + LDS_V;
#pragma unroll
    for (int i = 0; i < 8; ++i) { const int e = tid + 512 * i, row = e >> 4, ch = e & 15; const bf16_t* src = MEMKV + (size_t)(b * MEM_LEN + row) * 1024 + hd * 128 + ch * 8;
        const u32x4 kv = *(const u32x4*)src, vv = *(const u32x4*)(src + 512);
        *(LAS u32x4*)(Kl + row * 256 + ((ch ^ (row & 7)) << 4)) = kv; *(LAS u32x4*)(Vl + row * 256 + (ch << 4)) = vv; }
    __syncthreads();
    for (int qi = 0; qi < nq; ++qi) {
        const int lane = tid_opaque() & 63, r = lane & 31, hh = lane >> 5;
        const size_t qtok = (size_t)b * SEQ + 256 * (qt0 + qi) + 32 * wid + r; bf16_t* qrow = XQ + qtok * 512 + hd * 128;
        bf16x8 qf[8];
#pragma unroll
        for (int s = 0; s < 8; ++s) qf[s] = *(const bf16x8*)(qrow + 16 * s + 8 * hh);
        f32x16 o[4]; float l;
        xattn_wave(lane, Kl, Vl, qf, o, l);
        store_o<128>(hh, qrow, o, __builtin_amdgcn_rcpf(l));
    }
    __syncthreads();
}

__device__ __forceinline__ void combine_rows(bf16_t* QKV, const float* LSE, int gw, int ngw) {
    const int lane = threadIdx.x & 63; const int h = lane >> 4, c = (lane & 15) * 4;
    for (int tok = gw; tok < MTOK; tok += ngw) {
        const float l0 = LSE[(size_t)tok * 12 + h], l1 = LSE[(size_t)tok * 12 + 4 + h], l2 = LSE[(size_t)tok * 12 + 8 + h];
        const float mx = fmaxf(l0, fmaxf(l1, l2)); float w0 = __builtin_amdgcn_exp2f(l0 - mx), w1 = __builtin_amdgcn_exp2f(l1 - mx), w2 = __builtin_amdgcn_exp2f(l2 - mx);
        const float inv = __builtin_amdgcn_rcpf(w0 + w1 + w2); w0 *= inv; w1 *= inv; w2 *= inv;
        bf16_t* p = QKV + (size_t)tok * QKV_PITCH + h * 64 + c;
        const u32x2 a = *(const u32x2*)p, bq = *(const u32x2*)(p + 256), cq = *(const u32x2*)(p + 512);
        u32x2 w; w.x = cvt_pk_bf16(w0 * bf_lo(a.x) + w1 * bf_lo(bq.x) + w2 * bf_lo(cq.x), w0 * bf_hi(a.x) + w1 * bf_hi(bq.x) + w2 * bf_hi(cq.x));
        w.y = cvt_pk_bf16(w0 * bf_lo(a.y) + w1 * bf_lo(bq.y) + w2 * bf_lo(cq.y), w0 * bf_hi(a.y) + w1 * bf_hi(bq.y) + w2 * bf_hi(cq.y));
        *(u32x2*)p = w;
    }
}
}
namespace ssm {
constexpr int L_WP = 0, L_BB = L_WP + 65 * 64 * 2 * 4, L_CC = L_BB + 64 * 16 * 2 * 4, L_KT = L_CC + 16 * 64 * 2 * 4;
static_assert(L_KT + 64 * 32 * 4 <= 131072, "ssm lds");

__device__ __forceinline__ void build_item(LAS unsigned char* lds, int item, const float* a_re, const float* a_im, const float* log_dt, const float* b_re, const float* b_im,
                                           const float* c_re, const float* c_im, const float* dsk, bf16_t* LP, bf16_t* QT) {
    const int tid = threadIdx.x, g = item >> 3, sub = item & 7;
    LAS float* WP = (LAS float*)(lds + L_WP); LAS float* BB = (LAS float*)(lds + L_BB); LAS float* CC = (LAS float*)(lds + L_CC); LAS float* KT = (LAS float*)(lds + L_KT);
    const double dt = exp((double)log_dt[g]); const float dtf = (float)dt;
    for (int e = tid; e < 65 * 64; e += 512) { const int tau = e >> 6, p = e & 63; const float ar = a_re[g * 64 + p], ai = a_im[g * 64 + p];
        const float mag = expf(ar * dtf * (float)tau), ang = ai * dtf * (float)tau; float sn, cs; sincosf(ang, &sn, &cs); WP[2 * (p * 65 + tau)] = mag * cs; WP[2 * (p * 65 + tau) + 1] = mag * sn; }
    for (int e = tid; e < 1024; e += 512) { const int p = e >> 4, h = e & 15; const double ar = a_re[g * 64 + p], ai = a_im[g * 64 + p];
        const double mag = exp(ar * dt), ang = ai * dt, abr = mag * cos(ang), abi = mag * sin(ang), nr = abr - 1.0, ni = abi, den = ar * ar + ai * ai;
        const double cr = (nr * ar + ni * ai) / den, ci = (ni * ar - nr * ai) / den; const double br = b_re[(g * 64 + p) * 16 + h], bi = b_im[(g * 64 + p) * 16 + h];
        BB[2 * e] = (float)(cr * br - ci * bi); BB[2 * e + 1] = (float)(cr * bi + ci * br);
        CC[2 * e] = c_re[(g * 16 + h) * 64 + p]; CC[2 * e + 1] = c_im[(g * 16 + h) * 64 + p]; }
    __syncthreads();
    { const int tau = tid >> 3, hs = (tid >> 2) & 1, hp0 = (tid & 3) * 4, h = 2 * sub + hs; float s0 = 0.f, s1 = 0.f, s2 = 0.f, s3 = 0.f;
        for (int p = 0; p < 64; ++p) { const f32x2 c = *(const LAS f32x2*)(CC + 2 * (p * 16 + h)), w = *(const LAS f32x2*)(WP + 2 * (p * 65 + tau));
            const float cwr = c.x * w.x - c.y * w.y, cwi = c.x * w.y + c.y * w.x; const LAS f32x2* bb = (const LAS f32x2*)(BB + 2 * (p * 16 + hp0));
            s0 += cwr * bb[0].x - cwi * bb[0].y; s1 += cwr * bb[1].x - cwi * bb[1].y; s2 += cwr * bb[2].x - cwi * bb[2].y; s3 += cwr * bb[3].x - cwi * bb[3].y; }
        if (tau == 0 && h >= hp0 && h < hp0 + 4) { const float dv = dsk[g * 16 + h]; if (h == hp0) s0 += dv; else if (h == hp0 + 1) s1 += dv; else if (h == hp0 + 2) s2 += dv; else s3 += dv; }
        *(LAS f32x4*)(KT + (tau * 2 + hs) * 16 + hp0) = (f32x4){s0, s1, s2, s3}; }
    __syncthreads();
    bf16_t* lp = LP + (size_t)g * 256 * LP_PITCH;
    for (int e = tid; e < 32 * 128; e += 512) { const int rr = e >> 7, c8 = e & 127, tl = rr >> 1, hs = rr & 1, n = tl * 16 + 2 * sub + hs, si = c8 >> 1, hp0 = (c8 & 1) * 8; const int tau = tl + 48 - si;
        u32x4 w = {0u, 0u, 0u, 0u};
        if (tau >= 0 && tau <= 63) { const LAS float* k = KT + (tau * 2 + hs) * 16 + hp0; w.x = cvt_pk_bf16(k[0], k[1]); w.y = cvt_pk_bf16(k[2], k[3]); w.z = cvt_pk_bf16(k[4], k[5]); w.w = cvt_pk_bf16(k[6], k[7]); }
        *(u32x4*)(lp + (size_t)n * LP_PITCH + c8 * 8) = w; }
    for (int e = tid; e < 32 * 64; e += 512) { const int rr = e >> 6, q = e & 63, j = q >> 4, p0 = (q & 15) * 4, tl = rr >> 1, hs = rr & 1, h = 2 * sub + hs, n = tl * 16 + h, tau = 16 * j + tl + 1; float v[8];
#pragma unroll
        for (int i = 0; i < 4; ++i) { const int p = p0 + i; const float cr = CC[2 * (p * 16 + h)], ci = CC[2 * (p * 16 + h) + 1], wr = WP[2 * (p * 65 + tau)], wi = WP[2 * (p * 65 + tau) + 1];
            v[2 * i] = cr * wr - ci * wi; v[2 * i + 1] = -(cr * wi + ci * wr); }
        u32x4 w; w.x = cvt_pk_bf16(v[0], v[1]); w.y = cvt_pk_bf16(v[2], v[3]); w.z = cvt_pk_bf16(v[4], v[5]); w.w = cvt_pk_bf16(v[6], v[7]);
        *(u32x4*)(lp + (size_t)n * LP_PITCH + 1024 + 128 * j + 2 * p0) = w; }
    bf16_t* qt = QT + (size_t)g * 128 * 1024;
    for (int e = tid; e < 16 * 128; e += 512) { const int rw = 16 * sub + (e >> 7), c8 = e & 127, p = rw >> 1, ri = rw & 1, s = c8 >> 1, hp0 = (c8 & 1) * 8; const int tau = 63 - s;
        const float wr = WP[2 * (p * 65 + tau)], wi = WP[2 * (p * 65 + tau) + 1]; float v[8];
#pragma unroll
        for (int i = 0; i < 8; ++i) { const float br = BB[2 * (p * 16 + hp0 + i)], bi = BB[2 * (p * 16 + hp0 + i) + 1]; v[i] = ri ? (wr * bi + wi * br) : (wr * br - wi * bi); }
        u32x4 w; w.x = cvt_pk_bf16(v[0], v[1]); w.y = cvt_pk_bf16(v[2], v[3]); w.z = cvt_pk_bf16(v[4], v[5]); w.w = cvt_pk_bf16(v[6], v[7]);
        *(u32x4*)(qt + (size_t)rw * 1024 + c8 * 8) = w; }
    __syncthreads();
}

__device__ __forceinline__ void carry_scan(int gthread, const float* a_re, const float* a_im, const float* log_dt, const float* SLOC, bf16_t* AG) {
    if (gthread >= 32 * 4 * 64) return;
    const int p = gthread & 63, b = (gthread >> 6) & 3, g = gthread >> 8;
    const double dt = exp((double)log_dt[g]); const double ar = a_re[g * 64 + p], ai = a_im[g * 64 + p]; const double mag = exp(ar * dt * 64.0), ang = ai * dt * 64.0;
    const float wr = (float)(mag * cos(ang)), wi = (float)(mag * sin(ang));
    float xr = 0.f, xi = 0.f;
    const f32x2* sl = (const f32x2*)(SLOC + ((size_t)g * 512 + b * 128) * 128) + p; unsigned* xo = (unsigned*)(AG + ((size_t)g * 512 + b * 128) * AG_PITCH + 1024) + p;
    for (int c0 = 0; c0 < 128; c0 += 32) {
        f32x2 s[32];
#pragma unroll
        for (int i = 0; i < 32; ++i) s[i] = sl[(size_t)(c0 + i) * 64];
#pragma unroll
        for (int i = 0; i < 32; ++i) { xo[(size_t)(c0 + i) * (AG_PITCH / 2)] = cvt_pk_bf16(xr, xi); const float nr = wr * xr - wi * xi + s[i].x, ni = wr * xi + wi * xr + s[i].y; xr = nr; xi = ni; }
    }
}
}

namespace prep {
__device__ __forceinline__ void transpose_item(const float* W, int K, int N, bf16_t* WT, int half, const float* gain, LAS float* scr, int item, int lane) {
    const int nblk = N / 32, kb = item / nblk, nb = item % nblk, k0 = 64 * kb, n0 = 32 * nb;
    float v[32];
#pragma unroll
    for (int i = 0; i < 32; ++i) { const int kk = 2 * i + (lane >> 5); v[i] = W[(size_t)(k0 + kk) * N + n0 + (lane & 31)]; }
    if (gain) {
#pragma unroll
        for (int i = 0; i < 32; ++i) v[i] *= gain[k0 + 2 * i + (lane >> 5)]; }
#pragma unroll
    for (int i = 0; i < 32; ++i) { const int kk = 2 * i + (lane >> 5); scr[kk * 33 + (lane & 31)] = v[i]; }
    asm volatile("s_waitcnt lgkmcnt(0)" ::: "memory");
    const int c = lane & 7;
#pragma unroll
    for (int j = 0; j < 4; ++j) { const int nl = (lane >> 3) + 8 * j; const LAS float* s = scr + (8 * c) * 33 + nl; int n = n0 + nl, row = n;
        if (half > 0) { const int isb = n >= half; const int cc = isb ? n - half : n; row = (cc >> 7) * 256 + (isb ? 128 : 0) + (cc & 127); }
        u32x4 o; o.x = cvt_pk_bf16(s[0 * 33], s[1 * 33]); o.y = cvt_pk_bf16(s[2 * 33], s[3 * 33]); o.z = cvt_pk_bf16(s[4 * 33], s[5 * 33]); o.w = cvt_pk_bf16(s[6 * 33], s[7 * 33]);
        *(u32x4*)(WT + (size_t)row * K + k0 + 8 * c) = o; }
    asm volatile("s_waitcnt lgkmcnt(0)" ::: "memory");
}
__device__ __forceinline__ void row_to_bf16(const float* xrow, bf16_t* orow, float* ss, int lane) {
    const f32x4* xr = (const f32x4*)xrow + lane; f32x4 v[4]; float s = 0.f;
#pragma unroll
    for (int j = 0; j < 4; ++j) { v[j] = xr[64 * j]; s += (v[j][0] * v[j][0] + v[j][1] * v[j][1]) + (v[j][2] * v[j][2] + v[j][3] * v[j][3]); }
    s = wave_sum(s);
    u32x2* o8 = (u32x2*)orow + lane;
#pragma unroll
    for (int j = 0; j < 4; ++j) { u32x2 w; w.x = cvt_pk_bf16(v[j][0], v[j][1]); w.y = cvt_pk_bf16(v[j][2], v[j][3]); o8[64 * j] = w; }
    if (lane == 0) *ss = s;
}
__device__ __forceinline__ void final_row(float* xrow, const float* ss4, int row, const float* gain, int lane) {
    const float r = rsqrtf(((ss4[row] + ss4[MTOK + row]) + (ss4[2 * MTOK + row] + ss4[3 * MTOK + row])) * (1.f / D_MODEL) + EPS);
    f32x4* xr = (f32x4*)xrow + lane; const f32x4* gr = (const f32x4*)gain + lane;
#pragma unroll
    for (int j = 0; j < 4; ++j) { const f32x4 v = xr[64 * j], g = gr[64 * j]; xr[64 * j] = v * r * g; }
}
}
#define RLX_AGENT __ATOMIC_RELAXED, __HIP_MEMORY_SCOPE_AGENT
#define XB_TMO      128
#define XB_XCNT(j)  (256  + 64 * (j))
#define XB_XSUB(j)  (1280 + 64 * (j))
#define XB_XGEN(j)  (2304 + 64 * (j))
#define XB_TOP      3328
#define XB_TOPGEN   3392
#define XCD_BAR_WORDS 3456
#define XB_SPIN_CAP (1u << 22)
__device__ __forceinline__ unsigned xb_ld(unsigned* p)              { return __hip_atomic_load(p, __ATOMIC_RELAXED, __HIP_MEMORY_SCOPE_AGENT); }
__device__ __forceinline__ unsigned xb_add(unsigned* p, unsigned v) { return __hip_atomic_fetch_add(p, v, __ATOMIC_RELAXED, __HIP_MEMORY_SCOPE_AGENT); }
__device__ __forceinline__ unsigned xb_xcc_id() { return (unsigned)__builtin_amdgcn_s_getreg((3 << 11) | 20) & 0xFu; }
#define XB_SPIN(cond, bar) do { unsigned _sp = 0; while (cond) { __builtin_amdgcn_s_sleep(1); \
    if ((++_sp & 255u) == 0u) { if (xb_ld(&(bar)[XB_TMO])) break; if (_sp > XB_SPIN_CAP) { atomicAdd(&(bar)[XB_TMO], 1u); break; } } } } while (0)
struct XcdBarrier { unsigned* bar; unsigned x; volatile LAS unsigned* st; };
__device__ __forceinline__ XcdBarrier xcd_barrier_post(unsigned* bar, volatile LAS unsigned* st) {
    XcdBarrier b; b.bar = bar; b.x = xb_xcc_id(); b.st = st;
    if (threadIdx.x == 0) (void)xb_add(&bar[XB_XCNT(b.x)], 1u);
    return b;
}
__device__ __forceinline__ void xcd_barrier_complete(unsigned* bar, unsigned x, unsigned& nloc, unsigned& nx) {
    const unsigned G = gridDim.x * gridDim.y * gridDim.z;
    unsigned sum, cnt, mine, sp = 0u;
    for (;;) {
        sum = 0u; cnt = 0u; mine = 0u;
#pragma unroll
        for (unsigned j = 0; j < 16; ++j) { const unsigned c = xb_ld(&bar[XB_XCNT(j)]); sum += c; cnt += (c > 0u) ? 1u : 0u; mine = (j == x) ? c : mine; }
        if (sum == G) break;
        __builtin_amdgcn_s_sleep(1);
        if ((++sp & 255u) == 0u) { if (xb_ld(&bar[XB_TMO])) break; if (sp > XB_SPIN_CAP) { atomicAdd(&bar[XB_TMO], 1u); break; } }
    }
    nloc = mine > 0u ? mine : 1u; nx = cnt > 0u ? cnt : 1u;
}
__device__ __forceinline__ void xcd_barrier(const XcdBarrier& b) {
    asm volatile("s_waitcnt vmcnt(0)" ::: "memory");
    __syncthreads();
    if (threadIdx.x == 0) {
        unsigned* bar = b.bar;
        __builtin_amdgcn_s_waitcnt(0);
        unsigned nloc = b.st[0], nx = b.st[1];
        if (nloc == 0u) { xcd_barrier_complete(bar, b.x, nloc, nx); b.st[0] = nloc; b.st[1] = nx; }
        const unsigned old = xb_add(&bar[XB_XSUB(b.x)], 1u);
        const unsigned gen = old / nloc;
        if (old + 1u == (gen + 1u) * nloc) {
            __builtin_amdgcn_fence(__ATOMIC_RELEASE, "agent");
            asm volatile("s_waitcnt vmcnt(0)" ::: "memory");
            const unsigned og = xb_add(&bar[XB_TOP], 1u);
            const unsigned tg = og / nx;
            if (og + 1u == (tg + 1u) * nx) xb_add(&bar[XB_TOPGEN], 1u);
            else XB_SPIN(xb_ld(&bar[XB_TOPGEN]) == tg, bar);
            __builtin_amdgcn_fence(__ATOMIC_ACQUIRE, "agent");
            xb_add(&bar[XB_XGEN(b.x)], 1u);
            asm volatile("s_waitcnt vmcnt(0)" ::: "memory");
        } else {
            XB_SPIN(xb_ld(&bar[XB_XGEN(b.x)]) == gen, bar);
            __builtin_amdgcn_fence(__ATOMIC_ACQUIRE, "agent");
            asm volatile("s_waitcnt vmcnt(0)" ::: "memory");
        }
    }
    __syncthreads();
}

constexpr int LDS_STAGE = 0;
constexpr int LDS_EPI = 131072;
constexpr int LDS_BIASTAB = 131072 + 4096;
constexpr int LDS_MISC = 131072 + 4096 + 1024;
constexpr int LDS_BYTES = 147456;
constexpr int NPHASE = 15;

struct Args { const float* in[26]; float* out; unsigned char* ws; int ph_lo, ph_hi; };
__device__ __forceinline__ int tid_now() { int t = threadIdx.x; asm volatile("" : "+v"(t)); return t; }
#define PHASE_IDS const int tid = tid_now(), lane = tid & 63, wave = __builtin_amdgcn_readfirstlane(tid >> 6), gw = c * 8 + wave, NGW = G * 8; LAS float* scr = (LAS float*)(lds + LDS_STAGE + wave * 16384); (void)lane; (void)gw; (void)NGW; (void)scr;

__global__ void __launch_bounds__(512, 2) mega_fwd(Args args) {
    extern __shared__ __attribute__((aligned(16))) unsigned char lds_raw[];
    LAS unsigned char* lds = (LAS unsigned char*)lds_raw;
    const int G = gridDim.x, c = blockIdx.x;
    unsigned char* ws = args.ws;
    const float* const* in = args.in;
    volatile LAS unsigned* MISC = (volatile LAS unsigned*)(lds + LDS_MISC);
    if (threadIdx.x < 64) MISC[threadIdx.x] = 0u;
    __syncthreads();
    const int lo = args.ph_lo, hi = args.ph_hi;
    const bool multi = (hi - lo) > 1;
    XcdBarrier bar; bar.bar = (unsigned*)(ws + WS_CTL); bar.x = 0; bar.st = nullptr;
    if (multi) bar = xcd_barrier_post((unsigned*)(ws + WS_CTL), MISC);
#define IN(k) (lo <= (k) && (k) < hi)
#ifdef PROBE_LO
    unsigned long long tstamp[NPHASE + 1]; const bool stamper = (c == 0 && threadIdx.x == 0);
    tstamp[0] = __builtin_amdgcn_s_memrealtime();
#define SEAM(k) do { if (IN(k) && IN((k) + 1)) xcd_barrier(bar); if ((k) + 1 == PROBE_LO) tstamp[0] = __builtin_amdgcn_s_memrealtime(); if ((k) == PROBE_HI) tstamp[1] = __builtin_amdgcn_s_memrealtime(); } while (0)
#else
#define SEAM(k) do { if (IN(k) && IN((k) + 1)) xcd_barrier(bar); } while (0)
#endif

    float* OUT = args.out;
    float* SS1 = (float*)(ws + WS_SS1); float* SS2 = (float*)(ws + WS_SS2); float* SS3 = (float*)(ws + WS_SS3); float* SS4 = (float*)(ws + WS_SS4); float* SSMEM = (float*)(ws + WS_SSM);
    bf16_t* MEMB = (bf16_t*)(ws + WS_MEMB); bf16_t* MEMKV = (bf16_t*)(ws + WS_MEMKV);
    bf16_t* WIN = (bf16_t*)(ws + WS_WIN); bf16_t* WGLU = (bf16_t*)(ws + WS_WGLU); bf16_t* WAU = (bf16_t*)(ws + WS_WAU); bf16_t* WKV = (bf16_t*)(ws + WS_WKV);
    bf16_t* WMU = (bf16_t*)(ws + WS_WMU); bf16_t* WOUT = (bf16_t*)(ws + WS_WOUT); bf16_t* WFIN = (bf16_t*)(ws + WS_WFIN); bf16_t* WFDN = (bf16_t*)(ws + WS_WFDN);
    bf16_t* XB = (bf16_t*)(ws + WS_XB); bf16_t* LP = (bf16_t*)(ws + WS_LP); bf16_t* QT = (bf16_t*)(ws + WS_QT); float* SLOC = (float*)(ws + WS_SLOC); float* LSE = (float*)(ws + WS_LSE);
    bf16_t* HB = (bf16_t*)(ws + WS_H); bf16_t* QKV = (bf16_t*)(ws + WS_QKV); bf16_t* XQ = (bf16_t*)(ws + WS_XQ); bf16_t* AG = (bf16_t*)(ws + WS_AG); bf16_t* GATE = (bf16_t*)(ws + WS_GATE);
    bf16_t* GATE_S = GATE; bf16_t* MERGED = GATE + (size_t)MTOK * D_MODEL; bf16_t* GATE_M = GATE + 2 * (size_t)MTOK * D_MODEL;

    if (IN(0)) { PHASE_IDS
        constexpr int I_FIN = 16 * 176, I_FDN = 44 * 32, I_WIN = 16 * 200, I_GLU = 8 * 64, I_AU = 4 * 32, I_KV = 16 * 32, I_MU = 8 * 32, I_OUT = 16 * 32;
        constexpr int NIT = I_FIN + I_FDN + I_WIN + I_GLU + I_AU + I_KV + I_MU + I_OUT;
        for (int it = gw; it < NIT; it += NGW) { int r = it;
            if (r < I_FIN) { prep::transpose_item(in[3], 1024, 5632, WFIN, 2816, in[2], scr, r, lane); continue; } r -= I_FIN;
            if (r < I_FDN) { prep::transpose_item(in[4], 2816, 1024, WFDN, 0, nullptr, scr, r, lane); continue; } r -= I_FDN;
            if (r < I_WIN) { prep::transpose_item(in[6], 1024, 6400, WIN, 0, in[5], scr, r, lane); continue; } r -= I_WIN;
            if (r < I_GLU) { prep::transpose_item(in[15], 512, 2048, WGLU, 1024, nullptr, scr, r, lane); continue; } r -= I_GLU;
            if (r < I_AU) { prep::transpose_item(in[17], 256, 1024, WAU, 0, nullptr, scr, r, lane); continue; } r -= I_AU;
            if (r < I_KV) { prep::transpose_item(in[19], 1024, 1024, WKV, 0, in[18], scr, r, lane); continue; } r -= I_KV;
            if (r < I_MU) { prep::transpose_item(in[20], 512, 1024, WMU, 0, nullptr, scr, r, lane); continue; } r -= I_MU;
            prep::transpose_item(in[21], 1024, 1024, WOUT, 0, nullptr, scr, r, lane);
        }
        for (int m = gw; m < MTOK; m += NGW) prep::row_to_bf16(in[0] + (size_t)m * D_MODEL, XB + (size_t)m * D_MODEL, SS1 + m, lane);
        for (int m = gw; m < MEMROWS; m += NGW) prep::row_to_bf16(in[1] + (size_t)m * D_MODEL, MEMB + (size_t)m * D_MODEL, SSMEM + m, lane);
    }
    SEAM(0);
    if (IN(1)) {
        g8::OrdDense S{(const char*)XB, (const char*)WFIN, 128, 22, 16, G, c, (size_t)256 * 1024 * 2, (size_t)256 * 1024 * 2};
        g8::EpiSwiglu E{HB, SS1, 1};
        g8::gemm_phase<g8::EpiSwiglu, g8::OrdDense, false>(lds, g8::Cfg{1024, 1024, (size_t)128 * 1024 * 2, (size_t)128 * 1024 * 2}, S, E);
    }
    SEAM(1);
    if (IN(2)) {
        g8::OrdDense S{(const char*)HB, (const char*)WFDN, 128, 4, 44, G, c, (size_t)256 * D_FF * 2, (size_t)256 * D_FF * 2};
        g8::EpiResid E{in[0], OUT, XB, SS2, 0.5f};
        g8::gemm_phase<g8::EpiResid, g8::OrdDense, false>(lds, g8::Cfg{D_FF, D_FF, (size_t)128 * D_FF * 2, (size_t)128 * D_FF * 2}, S, E);
    }
    SEAM(2);
    if (IN(3)) {
        g8::OrdProj S{(const char*)XB, (const char*)WIN, (const char*)MEMB, (const char*)WKV, G, c};
        g8::EpiProj E{SS2, SSMEM, AG, QKV, XQ, GATE, MEMKV};
        g8::gemm_phase<g8::EpiProj, g8::OrdProj, false>(lds, g8::Cfg{1024, 1024, (size_t)128 * 1024 * 2, (size_t)128 * 1024 * 2}, S, E);
    }
    SEAM(3);
    if (IN(4)) {
        for (int it = c; it < 256; it += G) ssm::build_item(lds, it, in[7], in[8], in[9], in[10], in[11], in[12], in[13], in[14], LP, QT);
        for (int u = c; u < 1536; u += G) { const int x = u & 31, h = (u >> 5) & 3, rest = u >> 7, g = rest % 3, b = rest / 3; const int ntile = (g == 0) ? 32 : (g == 1 ? 8 : 2);
            att::dattn_unit(lds, QKV, LSE, in[16], b, g, h, x / ntile, x % ntile); }
        for (int pi = c; pi < 256; pi += G) att::xattn_units(lds, XQ, MEMKV, pi >> 6, (pi >> 4) & 3, 2 * (pi & 15), 2);
    }
    SEAM(4);
    if (IN(5)) { PHASE_IDS
        { g8::OrdSloc S{(const char*)AG, (const char*)QT, G, c}; g8::EpiSloc E{SLOC};
          g8::gemm_phase<g8::EpiSloc, g8::OrdSloc, false>(lds, g8::Cfg{AG_PITCH, 1024, (size_t)128 * AG_PITCH * 2, 0}, S, E); }
        att::combine_rows(QKV, LSE, gw, NGW);
        constexpr int I_FIN = 16 * 176, I_FDN = 44 * 32;
        for (int it = gw; it < I_FIN + I_FDN; it += NGW) {
            if (it < I_FIN) prep::transpose_item(in[23], 1024, 5632, WFIN, 2816, in[22], scr, it, lane);
            else prep::transpose_item(in[24], 2816, 1024, WFDN, 0, nullptr, scr, it - I_FIN, lane); }
    }
    SEAM(5);
    if (IN(6)) { if (c < 16) ssm::carry_scan(c * 512 + tid_now(), in[7], in[8], in[9], SLOC, AG); }
    SEAM(6);
    if (IN(7)) {
        g8::OrdY S{(const char*)AG, (const char*)LP, G, c}; g8::EpiY E{QKV + 768};
        g8::gemm_phase<g8::EpiY, g8::OrdY, true>(lds, g8::Cfg{AG_PITCH, LP_PITCH, (size_t)128 * AG_PITCH * 2, (size_t)128 * LP_PITCH * 2}, S, E);
    }
    SEAM(7);
    if (IN(8)) {
        g8::OrdDense S{(const char*)QKV, (const char*)WAU, 128, 4, 4, G, c, (size_t)256 * QKV_PITCH * 2, (size_t)256 * 256 * 2}; g8::EpiMerge<0> E{MERGED, MERGED};
        g8::gemm_phase<g8::EpiMerge<0>, g8::OrdDense, false>(lds, g8::Cfg{QKV_PITCH, 256, (size_t)128 * QKV_PITCH * 2, (size_t)128 * 256 * 2}, S, E);
    }
    SEAM(8);
    if (IN(9)) {
        g8::OrdDense S{(const char*)XQ, (const char*)WMU, 128, 4, 8, G, c, (size_t)256 * 512 * 2, (size_t)256 * 512 * 2}; g8::EpiMerge<1> E{GATE_M, MERGED};
        g8::gemm_phase<g8::EpiMerge<1>, g8::OrdDense, false>(lds, g8::Cfg{512, 512, (size_t)128 * 512 * 2, (size_t)128 * 512 * 2}, S, E);
    }
    SEAM(9);
    if (IN(10)) {
        g8::OrdDense S{(const char*)(QKV + 768), (const char*)WGLU, 128, 8, 8, G, c, (size_t)256 * QKV_PITCH * 2, (size_t)256 * 512 * 2}; g8::EpiMerge<2> E{GATE_S, MERGED};
        g8::gemm_phase<g8::EpiMerge<2>, g8::OrdDense, false>(lds, g8::Cfg{QKV_PITCH, 512, (size_t)128 * QKV_PITCH * 2, (size_t)128 * 512 * 2}, S, E);
    }
    SEAM(10);
    if (IN(11)) {
        g8::OrdDense S{(const char*)MERGED, (const char*)WOUT, 128, 4, 16, G, c, (size_t)256 * 1024 * 2, (size_t)256 * 1024 * 2}; g8::EpiResid E{OUT, OUT, XB, SS3, 1.0f};
        g8::gemm_phase<g8::EpiResid, g8::OrdDense, false>(lds, g8::Cfg{1024, 1024, (size_t)128 * 1024 * 2, (size_t)128 * 1024 * 2}, S, E);
    }
    SEAM(11);
    if (IN(12)) {
        g8::OrdDense S{(const char*)XB, (const char*)WFIN, 128, 22, 16, G, c, (size_t)256 * 1024 * 2, (size_t)256 * 1024 * 2}; g8::EpiSwiglu E{HB, SS3, 4};
        g8::gemm_phase<g8::EpiSwiglu, g8::OrdDense, false>(lds, g8::Cfg{1024, 1024, (size_t)128 * 1024 * 2, (size_t)128 * 1024 * 2}, S, E);
    }
    SEAM(12);
    if (IN(13)) {
        g8::OrdDense S{(const char*)HB, (const char*)WFDN, 128, 4, 44, G, c, (size_t)256 * D_FF * 2, (size_t)256 * D_FF * 2}; g8::EpiResid E{OUT, OUT, XB, SS4, 0.5f};
        g8::gemm_phase<g8::EpiResid, g8::OrdDense, false>(lds, g8::Cfg{D_FF, D_FF, (size_t)128 * D_FF * 2, (size_t)128 * D_FF * 2}, S, E);
    }
    SEAM(13);
    if (IN(14)) { PHASE_IDS for (int m = gw; m < MTOK; m += NGW) prep::final_row(OUT + (size_t)m * D_MODEL, SS4, m, in[25], lane); }
#ifdef PROBE_LO
    if (PROBE_HI == 14) { __syncthreads(); tstamp[1] = __builtin_amdgcn_s_memrealtime(); }
    if (stamper) { const unsigned long long want = (tstamp[1] - tstamp[0]) * PROBE_MULT, t1 = __builtin_amdgcn_s_memrealtime(); while (__builtin_amdgcn_s_memrealtime() - t1 < want) __builtin_amdgcn_s_sleep(8); }
#endif
#undef IN
#undef SEAM
}

#ifndef MK_MULTI
#define MK_MULTI 1
#endif
extern "C" void kernel_launch(void* const* d_in, const int* in_sizes, int n_in, void* d_out, int out_size, void* d_ws, size_t ws_size, hipStream_t stream) {
    static int grid = 0;
    if (!grid) {
        if (n_in != 26 || in_sizes[0] != MTOK * D_MODEL || out_size != MTOK * D_MODEL || ws_size < WS_END) { fprintf(stderr, "kernel_launch: unexpected problem: n_in %d, in0 %d, out %d, ws %zu (need %zu)\n", n_in, n_in > 0 ? in_sizes[0] : -1, out_size, ws_size, (size_t)WS_END); grid = -1; return; }
        if (hipFuncSetAttribute((const void*)mega_fwd, hipFuncAttributeMaxDynamicSharedMemorySize, LDS_BYTES) != hipSuccess) { fprintf(stderr, "kernel_launch: hipFuncSetAttribute failed\n"); grid = -1; return; }
        int dev = 0, cus = 0, per_cu = 0;
        if (hipGetDevice(&dev) != hipSuccess || hipDeviceGetAttribute(&cus, hipDeviceAttributeMultiprocessorCount, dev) != hipSuccess) { fprintf(stderr, "kernel_launch: device query failed\n"); grid = -1; return; }
        if (hipOccupancyMaxActiveBlocksPerMultiprocessor(&per_cu, (const void*)mega_fwd, 512, LDS_BYTES) != hipSuccess || per_cu < 1) { fprintf(stderr, "kernel_launch: occupancy query says %d blocks per CU\n", per_cu); grid = -1; return; }
        grid = cus;
        if (grid > 256) grid = 256;
        if (grid < 32) { fprintf(stderr, "kernel_launch: %d CUs is too few\n", cus); grid = -1; return; }
    }
    if (grid < 0) return;
    (void)hipMemsetAsync((char*)d_ws + WS_CTL, 0, 64 * 1024, stream);
    Args a{};
    for (int i = 0; i < 26; ++i) a.in[i] = (const float*)d_in[i];
    a.out = (float*)d_out; a.ws = (unsigned char*)d_ws;
#if MK_MULTI
    for (int p = 0; p < NPHASE; ++p) { a.ph_lo = p; a.ph_hi = p + 1; hipLaunchKernelGGL(mega_fwd, dim3(grid), dim3(512), LDS_BYTES, stream, a); }
#else
    a.ph_lo = 0; a.ph_hi = NPHASE;
    void* kargs[] = {&a};
    hipError_t e = hipLaunchCooperativeKernel((const void*)mega_fwd, dim3(grid), dim3(512), kargs, LDS_BYTES, stream);
    if (e != hipSuccess) fprintf(stderr, "kernel_launch: cooperative launch failed: %s (grid %d)\n", hipGetErrorString(e), grid);
#endif
}
```

```cpp
#include <hip/hip_runtime.h>
#include <cstdio>
#include <cstdint>
#include <cmath>
#define MK_MULTI 0
#define LAS __attribute__((address_space(3)))
#define GAS __attribute__((address_space(1)))
typedef unsigned short bf16_t;
typedef short bf16x8 __attribute__((ext_vector_type(8)));
typedef short s16x4 __attribute__((ext_vector_type(4)));
typedef float f32x4 __attribute__((ext_vector_type(4)));
typedef float f32x2 __attribute__((ext_vector_type(2)));
typedef float f32x16 __attribute__((ext_vector_type(16)));
typedef unsigned u32x4 __attribute__((ext_vector_type(4)));
typedef unsigned u32x2 __attribute__((ext_vector_type(2)));

constexpr int D_MODEL = 1024, NBATCH = 4, SEQ = 8192, MTOK = NBATCH * SEQ;
constexpr int D_FF = 2816, IN_WIDTH = 6400, MEM_LEN = 256, MEMROWS = NBATCH * MEM_LEN;
constexpr float EPS = 1e-6f;
constexpr float LOG2E = 1.4426950408889634f;

__device__ __forceinline__ unsigned cvt_pk_bf16(float lo, float hi) { unsigned r; asm volatile("v_cvt_pk_bf16_f32 %0, %1, %2" : "=v"(r) : "v"(lo), "v"(hi)); return r; }
__device__ __forceinline__ float bf_lo(unsigned w) { return __uint_as_float(w << 16); }
__device__ __forceinline__ float bf_hi(unsigned w) { return __uint_as_float(w & 0xffff0000u); }
__device__ __forceinline__ float fast_sigmoid(float v) { return __builtin_amdgcn_rcpf(1.f + __builtin_amdgcn_exp2f(-v * LOG2E)); }
__device__ __forceinline__ float gelu_tanh_f(float v) { const float z = 0.7978845608028654f * (v + 0.044715f * v * v * v); return v * __builtin_amdgcn_rcpf(1.f + __builtin_amdgcn_exp2f(-2.f * LOG2E * z)); }
__device__ __forceinline__ float wave_sum(float v) {
#pragma unroll
    for (int o = 1; o < 64; o <<= 1) v += __shfl_xor(v, o);
    return v;
}

constexpr size_t KiB = 1024;
constexpr size_t WS_CTL = 0;
constexpr size_t WS_SS1 = 64 * KiB;
constexpr size_t WS_SS2 = WS_SS1 + 128 * KiB;
constexpr size_t WS_SS3 = WS_SS2 + 512 * KiB;
constexpr size_t WS_SS4 = WS_SS3 + 512 * KiB;
constexpr size_t WS_SSM = WS_SS4 + 512 * KiB;
constexpr size_t WS_BIAS = WS_SSM + 4 * KiB;
constexpr size_t WS_MEMB = 1792 * KiB;
constexpr size_t WS_MEMKV = WS_MEMB + 2048 * KiB;
constexpr size_t WS_WIN = WS_MEMKV + 2048 * KiB;
constexpr size_t WS_WGLU = WS_WIN + 12800 * KiB;
constexpr size_t WS_WAU = WS_WGLU + 2048 * KiB;
constexpr size_t WS_WKV = WS_WAU + 512 * KiB;
constexpr size_t WS_WMU = WS_WKV + 2048 * KiB;
constexpr size_t WS_WOUT = WS_WMU + 1024 * KiB;
constexpr size_t WS_WFIN = WS_WOUT + 2048 * KiB;
constexpr size_t WS_WFDN = WS_WFIN + 11264 * KiB;
constexpr size_t WS_XB = WS_WFDN + 5632 * KiB;
constexpr size_t WS_LP = WS_XB;
constexpr size_t WS_QT = WS_LP + 24576 * KiB;
constexpr size_t WS_SLOC = WS_QT + 8192 * KiB;
constexpr size_t WS_LSE = WS_SLOC + 8192 * KiB;
constexpr size_t WS_BIG = WS_XB + 65536 * KiB;
constexpr size_t WS_H = WS_BIG;
constexpr size_t WS_QKV = WS_BIG;
constexpr size_t WS_XQ = WS_QKV + 147456 * KiB;
constexpr size_t WS_AG = WS_XQ + 32768 * KiB;
constexpr size_t WS_GATE = WS_AG + 36864 * KiB;
constexpr size_t WS_END = WS_GATE + 3 * 65536 * KiB;
static_assert(WS_BIAS + 12 * 192 * 4 <= WS_MEMB, "ws map");
static_assert(WS_LSE + 1536 * KiB <= WS_BIG, "ws map");
static_assert(WS_END <= (size_t)512 * 1024 * KiB, "ws map exceeds 512 MiB");
constexpr int QKV_PITCH = 2304, AG_PITCH = 1152, LP_PITCH = 1536;
namespace g8 {
constexpr int BM = 256, BK = 64, HALF = 128, HTB = HALF * BK * 2, STAGE_BYTES = 8 * HTB;

__host__ __device__ __forceinline__ int lds_byte(int r, int c) { const int st = (r >> 4) * 2 + (c >> 5), rr = r & 15, cc = c & 31, ob = rr * 64 + cc * 2; return st * 1024 + (ob ^ (((ob >> 9) & 1) << 5)); }
__host__ __device__ __forceinline__ void stage_rc(int b, int& R, int& C) { const int st = b / 1024, sb = b % 1024, swz = sb ^ (((sb >> 9) & 1) << 5); R = (st >> 1) * 16 + swz / 64; C = (st & 1) * 32 + (swz % 64) / 2; }
__host__ __device__ __forceinline__ int perm32(int rho) { const int n = rho >> 4, i = rho & 15; return 8 * (i >> 2) + 4 * n + (i & 3); }

struct Unit { const char* A; const char* B; int pm, pn, aux, nt, nt1, jumpA, jumpB; };
struct Cfg { int lda, ldb; size_t hstepA, hstepB; };

__device__ __forceinline__ void decode_tile(int L, int nM, int nN, int& pm, int& pn) {
    const int nwg = nM * nN; int wgid = L;
    { const int q = nwg / 8, r = nwg % 8, xcd = wgid % 8, off = wgid / 8; wgid = (xcd < r ? xcd * (q + 1) : r * (q + 1) + (xcd - r) * q) + off; }
    const int nig = 8 * nN, gid = wgid / nig, fm = gid * 8, gsz = (nM - fm) < 8 ? (nM - fm) : 8;
    pm = fm + ((wgid % nig) % gsz); pn = (wgid % nig) / gsz;
}

template <class Epi, class Sched, bool JUMP>
__device__ __forceinline__ void gemm_phase(LAS unsigned char* lds, const Cfg cfg, const Sched& S, const Epi& E) {
    const int tid = threadIdx.x, wid = __builtin_amdgcn_readfirstlane(tid >> 6), lane = tid & 63, wr = wid >> 2, wc = wid & 3, fr = lane & 15, fq = lane >> 4;
    unsigned voffA[2], voffB[2];
#pragma unroll
    for (int i = 0; i < 2; ++i) { int R, C; stage_rc(tid * 16 + i * 8192, R, C); const int Rb = Epi::PERM ? ((R & ~31) + perm32(R & 31)) : R;
        voffA[i] = (unsigned)(R * cfg.lda + C) * 2u; voffB[i] = (unsigned)(Rb * cfg.ldb + C) * 2u; }
    const size_t kstep = (size_t)(BK * 2);
    const size_t hsA = cfg.hstepA, hsB = cfg.hstepB;
    const unsigned ldsw = (unsigned)wid * 1024u;
    const int aoff = lds_byte(wr * 64 + fr, fq * 8), boff = lds_byte(wc * 32 + fr, fq * 8);
#define G8_SA(b, h) (((b) * 2 + (h)) * HTB)
#define G8_SB(b, h) ((4 + (b) * 2 + (h)) * HTB)
#define G8_STAGE(bufoff, gbase, voff) do { _Pragma("unroll") for (int _i = 0; _i < 2; ++_i) \
        __builtin_amdgcn_global_load_lds((const unsigned*)((const char*)(gbase) + (voff)[_i]), (LAS unsigned*)(lds + (bufoff) + ldsw + _i * 8192), 16, 0, 0); } while (0)
#define G8_LDA(dst, b, h) do { _Pragma("unroll") for (int m = 0; m < 4; ++m) _Pragma("unroll") for (int k = 0; k < 2; ++k) dst[m][k] = *(const LAS bf16x8*)(lds + G8_SA(b, h) + aoff + m * 2048 + k * 1024); } while (0)
#define G8_LDB(dst, b, h) do { _Pragma("unroll") for (int n = 0; n < 2; ++n) _Pragma("unroll") for (int k = 0; k < 2; ++k) dst[n][k] = *(const LAS bf16x8*)(lds + G8_SB(b, h) + boff + n * 2048 + k * 1024); } while (0)
#define G8_MMA(ai, bj, At, Bt) do { __builtin_amdgcn_s_setprio(1); _Pragma("unroll") for (int m = 0; m < 4; ++m) _Pragma("unroll") for (int n = 0; n < 2; ++n) _Pragma("unroll") for (int k = 0; k < 2; ++k) \
        acc[ai][bj][m][n] = __builtin_amdgcn_mfma_f32_16x16x32_bf16(Bt[n][k], At[m][k], acc[ai][bj][m][n], 0, 0, 0); __builtin_amdgcn_s_setprio(0); } while (0)
#define G8_WAIT_V(n) asm volatile("s_waitcnt vmcnt(" #n ")" ::: "memory")
#define G8_WAIT_L(n) asm volatile("s_waitcnt lgkmcnt(" #n ")" ::: "memory")
#define G8_BAR __builtin_amdgcn_s_barrier()
#define G8_SCHED __builtin_amdgcn_sched_barrier(0)
#define G8_KA(u, t) ((size_t)(t) * kstep + ((JUMP && (t) >= (u).nt1) ? (size_t)(long)(u).jumpA : (size_t)0))
#define G8_KB(u, t) ((size_t)(t) * kstep + ((JUMP && (t) >= (u).nt1) ? (size_t)(long)(u).jumpB : (size_t)0))
    Unit cur, nxt; int ui = 0;
    if (!S.next(0, cur)) return;
    f32x4 acc[2][2][4][2];
#pragma unroll
    for (int a = 0; a < 2; ++a)
#pragma unroll
        for (int b = 0; b < 2; ++b)
#pragma unroll
            for (int m = 0; m < 4; ++m)
#pragma unroll
                for (int n = 0; n < 2; ++n) acc[a][b][m][n] = (f32x4){0.f, 0.f, 0.f, 0.f};
    bf16x8 At[4][2], B0[2][2], B1[2][2];
    const char* cA = cur.A; const char* cB = cur.B;
    G8_STAGE(G8_SB(0, 0), cB, voffB); G8_STAGE(G8_SB(0, 1), cB + hsB, voffB); G8_STAGE(G8_SA(0, 0), cA, voffA); G8_STAGE(G8_SA(0, 1), cA + hsA, voffA);
    if (wr == 1) G8_BAR;
    G8_WAIT_V(2); G8_BAR;
    G8_STAGE(G8_SB(1, 0), cB + kstep, voffB); G8_STAGE(G8_SA(1, 0), cA + kstep, voffA); G8_STAGE(G8_SB(1, 1), cB + hsB + kstep, voffB);
    G8_WAIT_V(6); G8_BAR;
    for (;;) {
        const bool has_next = S.next(ui + 1, nxt);
        const char* nA = has_next ? nxt.A : cA; const char* nB = has_next ? nxt.B : cB;
        const int nt = cur.nt;
        for (int t = 0; t < nt; t += 2) {
            const bool last = (t == nt - 2);
            const char* a1 = cA + G8_KA(cur, t + 1);
            const char* a2 = last ? nA : cA + G8_KA(cur, t + 2); const char* b2 = last ? nB : cB + G8_KB(cur, t + 2);
            const char* a3 = last ? nA + kstep : cA + G8_KA(cur, t + 3); const char* b3 = last ? nB + kstep : cB + G8_KB(cur, t + 3);
            G8_LDB(B0, 0, 0); G8_LDB(B1, 0, 1); G8_SCHED; G8_LDA(At, 0, 0); G8_STAGE(G8_SA(1, 1), a1 + hsA, voffA);
            G8_WAIT_V(8); G8_WAIT_L(0); G8_BAR; G8_MMA(0, 0, At, B0); G8_MMA(0, 1, At, B1); G8_BAR; G8_SCHED;
            G8_LDA(At, 0, 1); G8_STAGE(G8_SB(0, 0), b2, voffB); G8_STAGE(G8_SB(0, 1), b2 + hsB, voffB); G8_STAGE(G8_SA(0, 0), a2, voffA);
            G8_WAIT_V(8); G8_WAIT_L(0); G8_BAR; G8_MMA(1, 0, At, B0); G8_MMA(1, 1, At, B1); G8_BAR; G8_SCHED;
            G8_LDB(B0, 1, 0); G8_LDB(B1, 1, 1); G8_SCHED; G8_LDA(At, 1, 0); G8_STAGE(G8_SA(0, 1), a2 + hsA, voffA);
            G8_WAIT_V(8); G8_WAIT_L(0); G8_BAR; G8_MMA(0, 0, At, B0); G8_MMA(0, 1, At, B1); G8_BAR; G8_SCHED;
            G8_LDA(At, 1, 1); G8_STAGE(G8_SB(1, 0), b3, voffB); G8_STAGE(G8_SB(1, 1), b3 + hsB, voffB); G8_STAGE(G8_SA(1, 0), a3, voffA);
            G8_WAIT_V(8); G8_WAIT_L(0); G8_BAR; G8_MMA(1, 0, At, B0); G8_MMA(1, 1, At, B1); G8_BAR; G8_SCHED;
        }
        if (wr == 0) G8_BAR;
        E(acc, cur, wr, wc, fr, fq, lds);
        if (!has_next) break;
#pragma unroll
        for (int a = 0; a < 2; ++a)
#pragma unroll
            for (int b = 0; b < 2; ++b)
#pragma unroll
                for (int m = 0; m < 4; ++m)
#pragma unroll
                    for (int n = 0; n < 2; ++n) acc[a][b][m][n] = (f32x4){0.f, 0.f, 0.f, 0.f};
        cur = nxt; cA = nA; cB = nB; ++ui;
        if (wr == 1) G8_BAR;
    }
    G8_WAIT_V(0);
    G8_BAR;
#undef G8_SA
#undef G8_SB
#undef G8_STAGE
#undef G8_LDA
#undef G8_LDB
#undef G8_MMA
#undef G8_WAIT_V
#undef G8_WAIT_L
#undef G8_BAR
#undef G8_SCHED
#undef G8_KA
#undef G8_KB
}
}
namespace g8 {
constexpr int EPI_SCR = STAGE_BYTES;

__device__ __forceinline__ float row_rstd(const float* ss, int nparts, int stride, int row) {
    float s = ss[row];
    for (int i = 1; i < nparts; ++i) s += ss[(size_t)i * stride + row];
    return rsqrtf(s * (1.f / D_MODEL) + EPS);
}

struct EpiSwiglu {
    static constexpr bool PERM = true;
    bf16_t* H; const float* ss; int nparts;
    __device__ __forceinline__ void operator()(const f32x4 (&acc)[2][2][4][2], const Unit& u, int wr, int wc, int fr, int fq, LAS unsigned char*) const {
#pragma unroll
        for (int ai = 0; ai < 2; ++ai)
#pragma unroll
            for (int m = 0; m < 4; ++m) {
                const int row = u.pm * BM + ai * HALF + wr * 64 + m * 16 + fr;
                const float r = row_rstd(ss, nparts, MTOK, row);
                float hv[8];
#pragma unroll
                for (int n = 0; n < 2; ++n)
#pragma unroll
                    for (int j = 0; j < 4; ++j) { const float a = acc[ai][0][m][n][j] * r, b = acc[ai][1][m][n][j] * r; hv[n * 4 + j] = a * fast_sigmoid(a) * b; }
                u32x4 w; w.x = cvt_pk_bf16(hv[0], hv[1]); w.y = cvt_pk_bf16(hv[2], hv[3]); w.z = cvt_pk_bf16(hv[4], hv[5]); w.w = cvt_pk_bf16(hv[6], hv[7]);
                *(u32x4*)(H + (size_t)row * D_FF + u.pn * 128 + wc * 32 + fq * 8) = w;
            }
    }
};

struct EpiResid {
    static constexpr bool PERM = false;
    const float* xres; float* xout; bf16_t* xb; float* ssout; float alpha;
    __device__ __forceinline__ void operator()(const f32x4 (&acc)[2][2][4][2], const Unit& u, int wr, int wc, int fr, int fq, LAS unsigned char* lds) const {
        LAS float* scr = (LAS float*)(lds + EPI_SCR);
#pragma unroll
        for (int ai = 0; ai < 2; ++ai)
#pragma unroll
            for (int m = 0; m < 4; ++m) {
                const int lrow = ai * HALF + wr * 64 + m * 16 + fr; const size_t row = (size_t)u.pm * BM + lrow;
                float sq = 0.f;
#pragma unroll
                for (int bj = 0; bj < 2; ++bj)
#pragma unroll
                    for (int n = 0; n < 2; ++n) {
                        const size_t off = row * D_MODEL + u.pn * BM + bj * HALF + wc * 32 + n * 16 + fq * 4;
                        const f32x4 xr = *(const f32x4*)(xres + off); f32x4 o = xr + acc[ai][bj][m][n] * alpha;
                        *(f32x4*)(xout + off) = o; sq += (o[0] * o[0] + o[1] * o[1]) + (o[2] * o[2] + o[3] * o[3]);
                        u32x2 w; w.x = cvt_pk_bf16(o[0], o[1]); w.y = cvt_pk_bf16(o[2], o[3]); *(u32x2*)(xb + off) = w;
                    }
                sq += __shfl_xor(sq, 16); sq += __shfl_xor(sq, 32);
                if (fq == 0) scr[lrow * 4 + wc] = sq;
            }
        asm volatile("s_waitcnt lgkmcnt(0)" ::: "memory"); __builtin_amdgcn_s_barrier(); asm volatile("" ::: "memory");
        if (threadIdx.x < 256) { const int lrow = threadIdx.x; const f32x4 p = *(const LAS f32x4*)(scr + lrow * 4);
            ssout[(size_t)u.pn * MTOK + (size_t)u.pm * BM + lrow] = (p[0] + p[1]) + (p[2] + p[3]); }
        asm volatile("s_waitcnt lgkmcnt(0)" ::: "memory"); __builtin_amdgcn_s_barrier(); asm volatile("" ::: "memory");
    }
};

struct EpiProj {
    static constexpr bool PERM = true;
    const float* ss2; const float* ssm; bf16_t *AG, *QKV, *XQ, *GATE, *MEMKV;
    __device__ __forceinline__ void operator()(const f32x4 (&acc)[2][2][4][2], const Unit& u, int wr, int wc, int fr, int fq, LAS unsigned char*) const {
        const int pn = u.pn; const bool is_mem = (u.aux != 0);
        int kind; bf16_t* dst; int pitch; float scale = 1.f;
        if (is_mem) { kind = 0; dst = MEMKV + pn * 256; pitch = 1024; }
        else if (pn < 2) { kind = 2; dst = AG; pitch = 0; }
        else if (pn < 11) { kind = 0; dst = QKV + (pn - 2) * 256; pitch = QKV_PITCH; if (pn < 5) scale = 0.125f * LOG2E; }
        else if (pn < 13) { kind = 0; dst = XQ + (pn - 11) * 256; pitch = 512; scale = 0.08838834764831845f * LOG2E; }
        else { kind = 1; const int gi = (pn - 13) >> 2; dst = GATE + (size_t)gi * MTOK * D_MODEL + ((pn - 13) & 3) * 256; pitch = 1024; }
#pragma unroll
        for (int ai = 0; ai < 2; ++ai)
#pragma unroll
            for (int m = 0; m < 4; ++m) {
                const int row = u.pm * BM + ai * HALF + wr * 64 + m * 16 + fr;
                const float r = (is_mem ? rsqrtf(ssm[row] * (1.f / D_MODEL) + EPS) : row_rstd(ss2, 4, MTOK, row)) * scale;
#pragma unroll
                for (int bj = 0; bj < 2; ++bj) {
                    float v[8];
#pragma unroll
                    for (int n = 0; n < 2; ++n)
#pragma unroll
                        for (int j = 0; j < 4; ++j) { float x = acc[ai][bj][m][n][j] * r; if (kind == 1) x = fast_sigmoid(x); v[n * 4 + j] = x; }
                    u32x4 w; w.x = cvt_pk_bf16(v[0], v[1]); w.y = cvt_pk_bf16(v[2], v[3]); w.z = cvt_pk_bf16(v[4], v[5]); w.w = cvt_pk_bf16(v[6], v[7]);
                    const int col = bj * HALF + wc * 32 + fq * 8;
                    bf16_t* p;
                    if (kind == 2) { const int ch = pn * 256 + col, g = ch >> 4, h0 = ch & 15; const int b = row >> 13, l = row & 8191, c = l >> 6, t = l & 63;
                        p = AG + ((size_t)(g * 512 + b * 128 + c) * AG_PITCH + t * 16 + h0); }
                    else p = dst + (size_t)row * pitch + col;
                    *(u32x4*)p = w;
                }
            }
    }
};

struct EpiSloc {
    static constexpr bool PERM = false;
    float* SLOC;
    __device__ __forceinline__ void operator()(const f32x4 (&acc)[2][2][4][2], const Unit& u, int wr, int wc, int fr, int fq, LAS unsigned char*) const {
#pragma unroll
        for (int ai = 0; ai < 2; ++ai)
#pragma unroll
            for (int m = 0; m < 4; ++m) {
                const int row = u.pm * BM + ai * HALF + wr * 64 + m * 16 + fr;
#pragma unroll
                for (int n = 0; n < 2; ++n) *(f32x4*)(SLOC + (size_t)row * 128 + wc * 32 + n * 16 + fq * 4) = acc[ai][0][m][n];
            }
    }
};

struct EpiY {
    static constexpr bool PERM = true;
    bf16_t* Y;
    __device__ __forceinline__ void operator()(const f32x4 (&acc)[2][2][4][2], const Unit& u, int wr, int wc, int fr, int fq, LAS unsigned char*) const {
        const int g = u.pm >> 1, rt = u.pm & 1, j = u.pn;
#pragma unroll
        for (int ai = 0; ai < 2; ++ai)
#pragma unroll
            for (int m = 0; m < 4; ++m) {
                const int r = rt * 256 + ai * HALF + wr * 64 + m * 16 + fr; const int b = r >> 7, c = r & 127;
#pragma unroll
                for (int bj = 0; bj < 2; ++bj) {
                    const int col = bj * HALF + wc * 32 + fq * 8, tl = col >> 4, h0 = col & 15; const int tok = b * SEQ + c * 64 + j * 16 + tl;
                    float v[8];
#pragma unroll
                    for (int n = 0; n < 2; ++n)
#pragma unroll
                        for (int q = 0; q < 4; ++q) v[n * 4 + q] = gelu_tanh_f(acc[ai][bj][m][n][q]);
                    u32x4 w; w.x = cvt_pk_bf16(v[0], v[1]); w.y = cvt_pk_bf16(v[2], v[3]); w.z = cvt_pk_bf16(v[4], v[5]); w.w = cvt_pk_bf16(v[6], v[7]);
                    *(u32x4*)(Y + (size_t)tok * QKV_PITCH + g * 16 + h0) = w;
                }
            }
    }
};

template <int MODE> struct EpiMerge {
    static constexpr bool PERM = true;
    const bf16_t* gate; bf16_t* merged;
    __device__ __forceinline__ void operator()(const f32x4 (&acc)[2][2][4][2], const Unit& u, int wr, int wc, int fr, int fq, LAS unsigned char*) const {
#pragma unroll
        for (int ai = 0; ai < 2; ++ai)
#pragma unroll
            for (int m = 0; m < 4; ++m) {
                const size_t row = (size_t)u.pm * BM + ai * HALF + wr * 64 + m * 16 + fr;
#pragma unroll
                for (int bj = 0; bj < (MODE == 2 ? 1 : 2); ++bj) {
                    const size_t off = row * D_MODEL + (MODE == 2 ? u.pn * 128 : u.pn * BM + bj * HALF) + wc * 32 + fq * 8;
                    float v[8];
#pragma unroll
                    for (int n = 0; n < 2; ++n)
#pragma unroll
                        for (int q = 0; q < 4; ++q) v[n * 4 + q] = (MODE == 2) ? acc[ai][0][m][n][q] * fast_sigmoid(acc[ai][1][m][n][q]) : acc[ai][bj][m][n][q];
                    const u32x4 gw = *(const u32x4*)(gate + off);
                    float o[8];
#pragma unroll
                    for (int q = 0; q < 4; ++q) { o[2 * q] = bf_lo(gw[q]) * v[2 * q]; o[2 * q + 1] = bf_hi(gw[q]) * v[2 * q + 1]; }
                    if (MODE != 0) { const u32x4 mw = *(const u32x4*)(merged + off);
#pragma unroll
                        for (int q = 0; q < 4; ++q) { o[2 * q] += bf_lo(mw[q]); o[2 * q + 1] += bf_hi(mw[q]); } }
                    u32x4 w; w.x = cvt_pk_bf16(o[0], o[1]); w.y = cvt_pk_bf16(o[2], o[3]); w.z = cvt_pk_bf16(o[4], o[5]); w.w = cvt_pk_bf16(o[6], o[7]);
                    *(u32x4*)(merged + off) = w;
                }
            }
    }
};

struct OrdDense {
    const char* A; const char* B; int nM, nN, nt, G, c; size_t tstepA, tstepB;
    __device__ __forceinline__ bool next(int i, Unit& u) const {
        const long L = (long)i * G + c; if (L >= (long)nM * nN) return false;
        decode_tile((int)L, nM, nN, u.pm, u.pn); u.A = A + (size_t)u.pm * tstepA; u.B = B + (size_t)u.pn * tstepB; u.aux = 0; u.nt = nt; u.nt1 = nt; u.jumpA = 0; u.jumpB = 0; return true;
    }
};
struct OrdProj {
    const char *A, *B, *Am, *Bm; int G, c;
    __device__ __forceinline__ bool next(int i, Unit& u) const {
        const long L = (long)i * G + c; u.nt = 16; u.nt1 = 16; u.jumpA = 0; u.jumpB = 0;
        if (L < 3200) { decode_tile((int)L, 128, 25, u.pm, u.pn); u.A = A + (size_t)u.pm * (256 * 1024 * 2); u.B = B + (size_t)u.pn * (256 * 1024 * 2); u.aux = 0; return true; }
        if (L < 3216) { const int x = (int)L - 3200; u.pm = x >> 2; u.pn = x & 3; u.A = Am + (size_t)u.pm * (256 * 1024 * 2); u.B = Bm + (size_t)u.pn * (256 * 1024 * 2); u.aux = 1; return true; }
        return false;
    }
};
struct OrdSloc {
    const char *AG, *QT; int G, c;
    __device__ __forceinline__ bool next(int i, Unit& u) const {
        const long L = (long)i * G + c; if (L >= 64) return false;
        u.pm = (int)L; u.pn = 0; u.A = AG + (size_t)u.pm * (256 * AG_PITCH * 2); u.B = QT + (size_t)(u.pm >> 1) * (128 * 1024 * 2); u.aux = 0; u.nt = 16; u.nt1 = 16; u.jumpA = 0; u.jumpB = 0; return true;
    }
};
struct OrdY {
    const char *AG, *LP; int G, c;
    __device__ __forceinline__ bool next(int i, Unit& u) const {
        const long L = (long)i * G + c; if (L >= 256) return false;
        const int j = 3 - (int)(L >> 6), pm = (int)(L & 63);
        u.pm = pm; u.pn = j; u.aux = 0; u.A = AG + (size_t)pm * (256 * AG_PITCH * 2); u.B = LP + (size_t)(pm >> 1) * (256 * LP_PITCH * 2) + (size_t)(48 - 16 * j) * 16 * 2;
        u.nt1 = 4 * (j + 1); u.nt = u.nt1 + 2; u.jumpA = (1024 - 256 * (j + 1)) * 2; u.jumpB = (1024 + 128 * j - ((48 - 16 * j) * 16 + 256 * (j + 1))) * 2; return true;
    }
};
}
namespace att {
__device__ __forceinline__ int tid_opaque() { int t = threadIdx.x; asm volatile("" : "+v"(t)); return t; }
__device__ __forceinline__ int crow(int r, int hi) { return (r & 3) + 8 * (r >> 2) + 4 * hi; }
__device__ __forceinline__ s16x4 vtr(const LAS char* p) { typedef short v4i16_t __attribute__((ext_vector_type(4))); return __builtin_bit_cast(s16x4, __builtin_amdgcn_ds_read_tr16_b64_v4i16((LAS v4i16_t*)p)); }

template <int D> __device__ __forceinline__ f32x16 qk_tile(const LAS char* Kl, int krow, const bf16x8 (&qf)[D / 16], int hh) {
    const LAS char* kp = Kl + krow * (D * 2); const int sw = krow & 7; f32x16 s = {};
#pragma unroll
    for (int d0 = 0; d0 < D / 16; ++d0) { const bf16x8 kf = *(const LAS bf16x8*)(kp + (((2 * d0 + hh) ^ sw) << 4)); s = __builtin_amdgcn_mfma_f32_32x32x16_bf16(kf, qf[d0], s, 0, 0, 0); }
    return s;
}
template <int D> __device__ __forceinline__ void pv_tile(f32x16 (&o)[D / 32], const LAS char* vb, bf16x8 pb0, bf16x8 pb1) {
    constexpr int RB = D * 2;
#pragma unroll
    for (int db = 0; db < D / 32; ++db) {
        const s16x4 a0 = vtr(vb + db * 64), a1 = vtr(vb + db * 64 + 8 * RB), a2 = vtr(vb + db * 64 + 16 * RB), a3 = vtr(vb + db * 64 + 24 * RB);
        const bf16x8 v0 = (bf16x8){a0[0], a0[1], a0[2], a0[3], a1[0], a1[1], a1[2], a1[3]}, v1 = (bf16x8){a2[0], a2[1], a2[2], a2[3], a3[0], a3[1], a3[2], a3[3]};
        o[db] = __builtin_amdgcn_mfma_f32_32x32x16_bf16(v0, pb0, o[db], 0, 0, 0);
        o[db] = __builtin_amdgcn_mfma_f32_32x32x16_bf16(v1, pb1, o[db], 0, 0, 0);
    }
}
__device__ __forceinline__ void pack_p(const f32x16& p, bf16x8& pb0, bf16x8& pb1) {
    u32x4 w0, w1;
    w0.x = cvt_pk_bf16(p[0], p[1]); w0.y = cvt_pk_bf16(p[2], p[3]); w0.z = cvt_pk_bf16(p[4], p[5]); w0.w = cvt_pk_bf16(p[6], p[7]);
    w1.x = cvt_pk_bf16(p[8], p[9]); w1.y = cvt_pk_bf16(p[10], p[11]); w1.z = cvt_pk_bf16(p[12], p[13]); w1.w = cvt_pk_bf16(p[14], p[15]);
    pb0 = __builtin_bit_cast(bf16x8, w0); pb1 = __builtin_bit_cast(bf16x8, w1);
}
__device__ __forceinline__ float max16(const f32x16& s) {
    float a = fmaxf(fmaxf(s[0], s[1]), fmaxf(s[2], s[3])), b = fmaxf(fmaxf(s[4], s[5]), fmaxf(s[6], s[7])), c = fmaxf(fmaxf(s[8], s[9]), fmaxf(s[10], s[11])), d = fmaxf(fmaxf(s[12], s[13]), fmaxf(s[14], s[15]));
    return fmaxf(fmaxf(a, b), fmaxf(c, d));
}

__device__ __forceinline__ void dattn_wave(int lane, const LAS char* Kl, const LAS char* Vl, int krow0, const bf16x8 (&qf)[4], const LAS float* biasL, int first_ok, f32x16 (&o)[2], float& m_out, float& l_out) {
    const int r = lane & 31, hh = lane >> 5;
    f32x16 s[5];
#pragma unroll
    for (int kt = 0; kt < 5; ++kt) s[kt] = qk_tile<64>(Kl, krow0 + 32 * kt + r, qf, hh);
    __builtin_amdgcn_sched_barrier(0);
    float m = -INFINITY;
    const LAS float* bbase = biasL + (r - 4 * hh + 1);
#pragma unroll
    for (int kt = 0; kt < 5; ++kt) {
        const bool tile_ok = kt >= first_ok;
        float bb[16];
#pragma unroll
        for (int rg = 0; rg < 16; ++rg) bb[rg] = bbase[159 - 32 * kt - (rg & 3) - 8 * (rg >> 2)];
        asm volatile("" : "+v"(bb[0]), "+v"(bb[1]), "+v"(bb[2]), "+v"(bb[3]), "+v"(bb[4]), "+v"(bb[5]), "+v"(bb[6]), "+v"(bb[7]), "+v"(bb[8]), "+v"(bb[9]), "+v"(bb[10]), "+v"(bb[11]), "+v"(bb[12]), "+v"(bb[13]), "+v"(bb[14]), "+v"(bb[15]));
#pragma unroll
        for (int rg = 0; rg < 16; ++rg) { const int kl = crow(rg, hh);
            bool ok = tile_ok; if (kt == 0) ok = ok && (kl >= r); if (kt == 4) ok = ok && (kl <= r);
            const float v = s[kt][rg] + bb[rg]; s[kt][rg] = ok ? v : -INFINITY; }
        m = fmaxf(m, max16(s[kt]));
        __builtin_amdgcn_sched_barrier(0);
    }
    m = fmaxf(m, __shfl_xor(m, 32));
    float l = 0.f;
    o[0] = f32x16{}; o[1] = f32x16{};
    const int gi = lane >> 4, li = lane & 15;
    const LAS char* vb0 = Vl + (krow0 + 4 * (gi >> 1) + (li >> 2)) * 128 + (16 * (gi & 1) + 4 * (li & 3)) * 2;
#pragma unroll
    for (int kt = 0; kt < 5; ++kt) {
        float ps = 0.f;
#pragma unroll
        for (int rg = 0; rg < 16; ++rg) { s[kt][rg] = __builtin_amdgcn_exp2f(s[kt][rg] - m); ps += s[kt][rg]; }
        l += ps;
        bf16x8 pb0, pb1; pack_p(s[kt], pb0, pb1);
        pv_tile<64>(o, vb0 + kt * 32 * 128, pb0, pb1);
    }
    l += __shfl_xor(l, 32);
    m_out = m; l_out = l;
}

__device__ __forceinline__ void xattn_wave(int lane, const LAS char* Kl, const LAS char* Vl, const bf16x8 (&qf)[8], f32x16 (&o)[4], float& l_out) {
    const int r = lane & 31, hh = lane >> 5;
    const int gi = lane >> 4, li = lane & 15;
    const LAS char* vb0 = Vl + (4 * (gi >> 1) + (li >> 2)) * 256 + (16 * (gi & 1) + 4 * (li & 3)) * 2;
    float m = 0.f, l = 0.f;
#pragma unroll
    for (int db = 0; db < 4; ++db) o[db] = f32x16{};
#pragma unroll
    for (int ck = 0; ck < 4; ++ck) {
        f32x16 s[2];
#pragma unroll
        for (int t = 0; t < 2; ++t) s[t] = qk_tile<128>(Kl, 32 * (2 * ck + t) + r, qf, hh);
        float tm = fmaxf(max16(s[0]), max16(s[1]));
        tm = fmaxf(tm, __shfl_xor(tm, 32));
        if (ck == 0) m = tm;
        else { const float mn = fmaxf(m, tm), sc = __builtin_amdgcn_exp2f(m - mn); m = mn; l *= sc;
#pragma unroll
            for (int db = 0; db < 4; ++db) o[db] = o[db] * sc; }
#pragma unroll
        for (int t = 0; t < 2; ++t) {
            float ps = 0.f;
#pragma unroll
            for (int rg = 0; rg < 16; ++rg) { s[t][rg] = __builtin_amdgcn_exp2f(s[t][rg] - m); ps += s[t][rg]; }
            l += ps;
            bf16x8 pb0, pb1; pack_p(s[t], pb0, pb1);
            pv_tile<128>(o, vb0 + (2 * ck + t) * 32 * 256, pb0, pb1);
        }
    }
    l += __shfl_xor(l, 32);
    l_out = l;
}

template <int D> __device__ __forceinline__ void store_o(int hh, bf16_t* orow, const f32x16 (&o)[D / 32], float inv_l) {
#pragma unroll
    for (int db = 0; db < D / 32; ++db)
#pragma unroll
        for (int q4 = 0; q4 < 4; ++q4) { u32x2 w; w.x = cvt_pk_bf16(o[db][4 * q4] * inv_l, o[db][4 * q4 + 1] * inv_l); w.y = cvt_pk_bf16(o[db][4 * q4 + 2] * inv_l, o[db][4 * q4 + 3] * inv_l);
            *(u32x2*)(orow + 32 * db + 8 * q4 + 4 * hh) = w; }
}

__device__ const unsigned char BUCKETS[3][129] = {
{0,1,2,3,4,5,6,7,8,9,10,11,12,13,14,15,16,16,16,16,16,16,17,17,17,17,17,17,17,17,18,18,18,18,18,18,18,18,18,18,19,19,19,19,19,19,19,19,19,19,19,19,19,19,20,20,20,20,20,20,20,20,20,20,20,20,20,20,20,20,20,20,20,21,21,21,21,21,21,21,21,21,21,21,21,21,21,21,21,21,21,21,21,21,21,21,21,21,21,22,22,22,22,22,22,22,22,22,22,22,22,22,22,22,22,22,22,22,22,22,22,22,22,22,22,22,22,22,22},
{0,4,8,12,16,16,17,17,18,18,19,19,19,19,20,20,20,20,20,21,21,21,21,21,21,22,22,22,22,22,22,22,22,22,23,23,23,23,23,23,23,23,23,23,23,23,24,24,24,24,24,24,24,24,24,24,24,24,24,24,24,24,25,25,25,25,25,25,25,25,25,25,25,25,25,25,25,25,25,25,25,25,25,26,26,26,26,26,26,26,26,26,26,26,26,26,26,26,26,26,26,26,26,26,26,26,26,26,26,26,26,26,26,27,27,27,27,27,27,27,27,27,27,27,27,27,27,27,27},
{0,16,18,19,20,21,21,22,22,23,23,23,24,24,24,24,25,25,25,25,25,26,26,26,26,26,26,26,26,27,27,27,27,27,27,27,27,27,27,28,28,28,28,28,28,28,28,28,28,28,28,28,29,29,29,29,29,29,29,29,29,29,29,29,29,29,29,29,29,29,30,30,30,30,30,30,30,30,30,30,30,30,30,30,30,30,30,30,30,30,30,30,30,30,30,31,31,31,31,31,31,31,31,31,31,31,31,31,31,31,31,31,31,31,31,31,31,31,31,31,31,31,31,31,31,31,31,31,31}};

__device__ __forceinline__ void build_bias(const float* rel, float* tab, int idx) {
    if (idx >= 12 * 192) return; const int gh = idx / 192, i = idx % 192, g = gh >> 2, j = i - 32;
    tab[idx] = (j >= 0 && j <= 128) ? rel[(int)BUCKETS[g][j] * 12 + gh] * LOG2E : 0.f;
}
constexpr int LDS_K = 0, LDS_V = 65536, LDS_BIAS = 131072 + 4096;

struct DUnit { int b, g, h, rs, qt, dil; };
__device__ __forceinline__ DUnit dunit(int u) { DUnit d; const int x = u & 31, rest = u >> 7; d.h = (u >> 5) & 3; d.g = rest % 3; d.b = rest / 3; const int ntile = (d.g == 0) ? 32 : (d.g == 1 ? 8 : 2);
    d.rs = x / ntile; d.qt = x % ntile; d.dil = (d.g == 0) ? 1 : (d.g == 1 ? 4 : 16); return d; }
__device__ __forceinline__ void dattn_fetch(const DUnit& d, int tid, const bf16_t* QKV, const float* rel, u32x4 (&kv)[6], u32x4 (&vv)[6], bf16x8 (&qf)[4], float& bv) {
    const int lane = tid & 63, wid = tid >> 6, r = lane & 31, hh = lane >> 5;
    const int nk0 = 256 * d.qt - 128; const size_t hcol = (size_t)d.g * 256 + d.h * 64;
#pragma unroll
    for (int i = 0; i < 6; ++i) { const int e = tid + 512 * i, row = e >> 3, ch = e & 7; const int nk = nk0 + row;
        kv[i] = (u32x4){0u, 0u, 0u, 0u}; vv[i] = (u32x4){0u, 0u, 0u, 0u};
        if (nk >= 0) { const size_t tok = (size_t)d.b * SEQ + d.rs + (size_t)d.dil * nk; const bf16_t* src = QKV + tok * QKV_PITCH + hcol + ch * 8; kv[i] = *(const u32x4*)(src + 768); vv[i] = *(const u32x4*)(src + 1536); } }
    const int nq = 256 * d.qt + 32 * wid + r; const size_t qtok = (size_t)d.b * SEQ + d.rs + (size_t)d.dil * nq; const bf16_t* qrow = QKV + qtok * QKV_PITCH + hcol;
#pragma unroll
    for (int s = 0; s < 4; ++s) qf[s] = *(const bf16x8*)(qrow + 16 * s + 8 * hh);
    bv = (tid < 192) ? rel[(d.g * 4 + d.h) * 192 + tid] : 0.f;
}
__device__ __forceinline__ void dattn_units(LAS unsigned char* lds, bf16_t* QKV, float* LSE, const float* rel, int c, int G) {
    LAS char* Kl = (LAS char*)lds + LDS_K; LAS char* Vl = (LAS char*)lds + LDS_V; LAS float* biasL = (LAS float*)(lds + LDS_BIAS);
    int u = c; if (u >= 1536) return;
    DUnit d = dunit(u);
    u32x4 kv[6], vv[6]; bf16x8 qf[4]; float bv;
    dattn_fetch(d, tid_opaque(), QKV, rel, kv, vv, qf, bv);
    for (;;) {
        const int tid = tid_opaque(), lane = tid & 63, wid = __builtin_amdgcn_readfirstlane(tid >> 6), r = lane & 31, hh = lane >> 5;
#pragma unroll
        for (int i = 0; i < 6; ++i) { const int e = tid + 512 * i, row = e >> 3, ch = e & 7;
            *(LAS u32x4*)(Kl + row * 128 + ((ch ^ (row & 7)) << 4)) = kv[i]; *(LAS u32x4*)(Vl + row * 128 + (ch << 4)) = vv[i]; }
        if (tid < 192) biasL[tid] = bv;
        __syncthreads();
        const int un = u + G; const bool has_next = un < 1536; DUnit dn = d;
        u32x4 kvn[6], vvn[6]; bf16x8 qfn[4]; float bvn = 0.f;
        if (has_next) { dn = dunit(un); dattn_fetch(dn, tid, QKV, rel, kvn, vvn, qfn, bvn); }
        f32x16 o[2]; float m, l;
        dattn_wave(lane, Kl, Vl, 32 * wid, qf, biasL, (d.qt == 0) ? 4 - wid : 0, o, m, l);
        const int nq = 256 * d.qt + 32 * wid + r; const size_t qtok = (size_t)d.b * SEQ + d.rs + (size_t)d.dil * nq; bf16_t* qrow = QKV + qtok * QKV_PITCH + (size_t)d.g * 256 + d.h * 64;
        store_o<64>(hh, qrow, o, __builtin_amdgcn_rcpf(l));
        if (hh == 0) LSE[qtok * 12 + d.g * 4 + d.h] = m + __builtin_amdgcn_logf(l);
        __syncthreads();
        if (!has_next) break;
        u = un; d = dn; bv = bvn;
#pragma unroll
        for (int i = 0; i < 6; ++i) { kv[i] = kvn[i]; vv[i] = vvn[i]; }
#pragma unroll
        for (int s = 0; s < 4; ++s) qf[s] = qfn[s];
    }
}

__device__ __forceinline__ void xattn_units(LAS unsigned char* lds, bf16_t* XQ, const bf16_t* MEMKV, int b, int hd, int qt0, int nq) {
    const int tid = tid_opaque(), lane = tid & 63, wid = __builtin_amdgcn_readfirstlane(tid >> 6), r = lane & 31, hh = lane >> 5;
    LAS char* Kl = (LAS char*)lds + LDS_K; LAS char* Vl = (LAS char*)lds + LDS_V;
#pragma unroll
    for (int i = 0; i < 8; ++i) { const int e = tid + 512 * i, row = e >> 4, ch = e & 15; const bf16_t* src = MEMKV + (size_t)(b * MEM_LEN + row) * 1024 + hd * 128 + ch * 8;
        const u32x4 kv = *(const u32x4*)src, vv = *(const u32x4*)(src + 512);
        *(LAS u32x4*)(Kl + row * 256 + ((ch ^ (row & 7)) << 4)) = kv; *(LAS u32x4*)(Vl + row * 256 + (ch << 4)) = vv; }
    __syncthreads();
    for (int qi = 0; qi < nq; ++qi) {
        const int lane = tid_opaque() & 63, r = lane & 31, hh = lane >> 5;
        const size_t qtok = (size_t)b * SEQ + 256 * (qt0 + qi) + 32 * wid + r; bf16_t* qrow = XQ + qtok * 512 + hd * 128;
        bf16x8 qf[8];
#pragma unroll
        for (int s = 0; s < 8; ++s) qf[s] = *(const bf16x8*)(qrow + 16 * s + 8 * hh);
        f32x16 o[4]; float l;
        xattn_wave(lane, Kl, Vl, qf, o, l);
        store_o<128>(hh, qrow, o, __builtin_amdgcn_rcpf(l));
    }
    __syncthreads();
}

__device__ __forceinline__ void combine_rows(bf16_t* QKV, const float* LSE, int gw, int ngw) {
    const int lane = threadIdx.x & 63; const int h = lane >> 4, c = (lane & 15) * 4;
    for (int tok = gw; tok < MTOK; tok += ngw) {
        const float l0 = LSE[(size_t)tok * 12 + h], l1 = LSE[(size_t)tok * 12 + 4 + h], l2 = LSE[(size_t)tok * 12 + 8 + h];
        const float mx = fmaxf(l0, fmaxf(l1, l2)); float w0 = __builtin_amdgcn_exp2f(l0 - mx), w1 = __builtin_amdgcn_exp2f(l1 - mx), w2 = __builtin_amdgcn_exp2f(l2 - mx);
        const float inv = __builtin_amdgcn_rcpf(w0 + w1 + w2); w0 *= inv; w1 *= inv; w2 *= inv;
        bf16_t* p = QKV + (size_t)tok * QKV_PITCH + h * 64 + c;
        const u32x2 a = *(const u32x2*)p, bq = *(const u32x2*)(p + 256), cq = *(const u32x2*)(p + 512);
        u32x2 w; w.x = cvt_pk_bf16(w0 * bf_lo(a.x) + w1 * bf_lo(bq.x) + w2 * bf_lo(cq.x), w0 * bf_hi(a.x) + w1 * bf_hi(bq.x) + w2 * bf_hi(cq.x));
        w.y = cvt_pk_bf16(w0 * bf_lo(a.y) + w1 * bf_lo(bq.y) + w2 * bf_lo(cq.y), w0 * bf_hi(a.y) + w1 * bf_hi(bq.y) + w2 * bf_hi(cq.y));
        *(u32x2*)p = w;
    }
}
}
namespace ssm {
constexpr int L_WP = 0, L_BB = L_WP + 65 * 64 * 2 * 4, L_CC = L_BB + 64 * 16 * 2 * 4, L_KT = L_CC + 16 * 64 * 2 * 4;
static_assert(L_KT + 64 * 32 * 4 <= 131072, "ssm lds");

__device__ __forceinline__ void build_item(LAS unsigned char* lds, int item, const float* a_re, const float* a_im, const float* log_dt, const float* b_re, const float* b_im,
                                           const float* c_re, const float* c_im, const float* dsk, bf16_t* LP, bf16_t* QT) {
    const int tid = threadIdx.x, g = item >> 3, sub = item & 7;
    LAS float* WP = (LAS float*)(lds + L_WP); LAS float* BB = (LAS float*)(lds + L_BB); LAS float* CC = (LAS float*)(lds + L_CC); LAS float* KT = (LAS float*)(lds + L_KT);
    LAS float* CF = KT;
    if (tid < 64) { const int p = tid; const double dt = exp((double)log_dt[g]); const double ar = a_re[g * 64 + p], ai = a_im[g * 64 + p];
        const double mag = exp(ar * dt), ang = ai * dt, abr = mag * cos(ang), abi = mag * sin(ang), nr = abr - 1.0, ni = abi, den = ar * ar + ai * ai;
        CF[2 * p] = (float)((nr * ar + ni * ai) / den); CF[2 * p + 1] = (float)((ni * ar - nr * ai) / den);
        const float wr = (float)abr, wi = (float)abi; float xr = 1.f, xi = 0.f;
        for (int tau = 0; tau <= 64; ++tau) { WP[2 * (p * 65 + tau)] = xr; WP[2 * (p * 65 + tau) + 1] = xi; const float nxr = xr * wr - xi * wi, nxi = xr * wi + xi * wr; xr = nxr; xi = nxi; } }
    __syncthreads();
    for (int e = tid; e < 1024; e += 512) { const int p = e >> 4, h = e & 15; const float cr = CF[2 * p], ci = CF[2 * p + 1]; const float br = b_re[(g * 64 + p) * 16 + h], bi = b_im[(g * 64 + p) * 16 + h];
        BB[2 * e] = cr * br - ci * bi; BB[2 * e + 1] = cr * bi + ci * br;
        CC[2 * e] = c_re[(g * 16 + h) * 64 + p]; CC[2 * e + 1] = c_im[(g * 16 + h) * 64 + p]; }
    __syncthreads();
    { const int tau = tid >> 3, hs = (tid >> 2) & 1, hp0 = (tid & 3) * 4, h = 2 * sub + hs; float s0 = 0.f, s1 = 0.f, s2 = 0.f, s3 = 0.f;
        for (int p = 0; p < 64; ++p) { const f32x2 c = *(const LAS f32x2*)(CC + 2 * (p * 16 + h)), w = *(const LAS f32x2*)(WP + 2 * (p * 65 + tau));
            const float cwr = c.x * w.x - c.y * w.y, cwi = c.x * w.y + c.y * w.x; const LAS f32x2* bb = (const LAS f32x2*)(BB + 2 * (p * 16 + hp0));
            s0 += cwr * bb[0].x - cwi * bb[0].y; s1 += cwr * bb[1].x - cwi * bb[1].y; s2 += cwr * bb[2].x - cwi * bb[2].y; s3 += cwr * bb[3].x - cwi * bb[3].y; }
        if (tau == 0 && h >= hp0 && h < hp0 + 4) { const float dv = dsk[g * 16 + h]; if (h == hp0) s0 += dv; else if (h == hp0 + 1) s1 += dv; else if (h == hp0 + 2) s2 += dv; else s3 += dv; }
        *(LAS f32x4*)(KT + (tau * 2 + hs) * 16 + hp0) = (f32x4){s0, s1, s2, s3}; }
    __syncthreads();
    bf16_t* lp = LP + (size_t)g * 256 * LP_PITCH;
    for (int e = tid; e < 32 * 128; e += 512) { const int rr = e >> 7, c8 = e & 127, tl = rr >> 1, hs = rr & 1, n = tl * 16 + 2 * sub + hs, si = c8 >> 1, hp0 = (c8 & 1) * 8; const int tau = tl + 48 - si;
        u32x4 w = {0u, 0u, 0u, 0u};
        if (tau >= 0 && tau <= 63) { const LAS float* k = KT + (tau * 2 + hs) * 16 + hp0; w.x = cvt_pk_bf16(k[0], k[1]); w.y = cvt_pk_bf16(k[2], k[3]); w.z = cvt_pk_bf16(k[4], k[5]); w.w = cvt_pk_bf16(k[6], k[7]); }
        *(u32x4*)(lp + (size_t)n * LP_PITCH + c8 * 8) = w; }
    for (int e = tid; e < 32 * 64; e += 512) { const int rr = e >> 6, q = e & 63, j = q >> 4, p0 = (q & 15) * 4, tl = rr >> 1, hs = rr & 1, h = 2 * sub + hs, n = tl * 16 + h, tau = 16 * j + tl + 1; float v[8];
#pragma unroll
        for (int i = 0; i < 4; ++i) { const int p = p0 + i; const float cr = CC[2 * (p * 16 + h)], ci = CC[2 * (p * 16 + h) + 1], wr = WP[2 * (p * 65 + tau)], wi = WP[2 * (p * 65 + tau) + 1];
            v[2 * i] = cr * wr - ci * wi; v[2 * i + 1] = -(cr * wi + ci * wr); }
        u32x4 w; w.x = cvt_pk_bf16(v[0], v[1]); w.y = cvt_pk_bf16(v[2], v[3]); w.z = cvt_pk_bf16(v[4], v[5]); w.w = cvt_pk_bf16(v[6], v[7]);
        *(u32x4*)(lp + (size_t)n * LP_PITCH + 1024 + 128 * j + 2 * p0) = w; }
    bf16_t* qt = QT + (size_t)g * 128 * 1024;
    for (int e = tid; e < 16 * 128; e += 512) { const int rw = 16 * sub + (e >> 7), c8 = e & 127, p = rw >> 1, ri = rw & 1, s = c8 >> 1, hp0 = (c8 & 1) * 8; const int tau = 63 - s;
        const float wr = WP[2 * (p * 65 + tau)], wi = WP[2 * (p * 65 + tau) + 1]; float v[8];
#pragma unroll
        for (int i = 0; i < 8; ++i) { const float br = BB[2 * (p * 16 + hp0 + i)], bi = BB[2 * (p * 16 + hp0 + i) + 1]; v[i] = ri ? (wr * bi + wi * br) : (wr * br - wi * bi); }
        u32x4 w; w.x = cvt_pk_bf16(v[0], v[1]); w.y = cvt_pk_bf16(v[2], v[3]); w.z = cvt_pk_bf16(v[4], v[5]); w.w = cvt_pk_bf16(v[6], v[7]);
        *(u32x4*)(qt + (size_t)rw * 1024 + c8 * 8) = w; }
    __syncthreads();
}

__device__ __forceinline__ void carry_scan(int gthread, const float* a_re, const float* a_im, const float* log_dt, const float* SLOC, bf16_t* AG) {
    if (gthread >= 32 * 4 * 64) return;
    const int p = gthread & 63, b = (gthread >> 6) & 3, g = gthread >> 8;
    const double dt = exp((double)log_dt[g]); const double ar = a_re[g * 64 + p], ai = a_im[g * 64 + p]; const double mag = exp(ar * dt * 64.0), ang = ai * dt * 64.0;
    const float wr = (float)(mag * cos(ang)), wi = (float)(mag * sin(ang));
    float xr = 0.f, xi = 0.f;
    const f32x2* sl = (const f32x2*)(SLOC + ((size_t)g * 512 + b * 128) * 128) + p; unsigned* xo = (unsigned*)(AG + ((size_t)g * 512 + b * 128) * AG_PITCH + 1024) + p;
    for (int c0 = 0; c0 < 128; c0 += 32) {
        f32x2 s[32];
#pragma unroll
        for (int i = 0; i < 32; ++i) s[i] = sl[(size_t)(c0 + i) * 64];
#pragma unroll
        for (int i = 0; i < 32; ++i) { xo[(size_t)(c0 + i) * (AG_PITCH / 2)] = cvt_pk_bf16(xr, xi); const float nr = wr * xr - wi * xi + s[i].x, ni = wr * xi + wi * xr + s[i].y; xr = nr; xi = ni; }
    }
}
}

namespace prep {
__device__ __forceinline__ void transpose_item(const float* W, int K, int N, bf16_t* WT, int half, const float* gain, LAS float* scr, int item, int lane) {
    const int nblk = N / 32, kb = item / nblk, nb = item % nblk, k0 = 64 * kb, n0 = 32 * nb;
    float v[32];
#pragma unroll
    for (int i = 0; i < 32; ++i) { const int kk = 2 * i + (lane >> 5); v[i] = W[(size_t)(k0 + kk) * N + n0 + (lane & 31)]; }
    if (gain) {
#pragma unroll
        for (int i = 0; i < 32; ++i) v[i] *= gain[k0 + 2 * i + (lane >> 5)]; }
#pragma unroll
    for (int i = 0; i < 32; ++i) { const int kk = 2 * i + (lane >> 5); scr[kk * 33 + (lane & 31)] = v[i]; }
    asm volatile("s_waitcnt lgkmcnt(0)" ::: "memory");
    const int c = lane & 7;
#pragma unroll
    for (int j = 0; j < 4; ++j) { const int nl = (lane >> 3) + 8 * j; const LAS float* s = scr + (8 * c) * 33 + nl; int n = n0 + nl, row = n;
        if (half > 0) { const int isb = n >= half; const int cc = isb ? n - half : n; row = (cc >> 7) * 256 + (isb ? 128 : 0) + (cc & 127); }
        u32x4 o; o.x = cvt_pk_bf16(s[0 * 33], s[1 * 33]); o.y = cvt_pk_bf16(s[2 * 33], s[3 * 33]); o.z = cvt_pk_bf16(s[4 * 33], s[5 * 33]); o.w = cvt_pk_bf16(s[6 * 33], s[7 * 33]);
        *(u32x4*)(WT + (size_t)row * K + k0 + 8 * c) = o; }
    asm volatile("s_waitcnt lgkmcnt(0)" ::: "memory");
}
template <int NR> __device__ __forceinline__ void rows_to_bf16(const float* xrow, bf16_t* orow, float* ss, int lane) {
    f32x4 v[NR][4];
#pragma unroll
    for (int q = 0; q < NR; ++q)
#pragma unroll
        for (int j = 0; j < 4; ++j) v[q][j] = ((const f32x4*)(xrow + (size_t)q * D_MODEL) + lane)[64 * j];
#pragma unroll
    for (int q = 0; q < NR; ++q) { float s = 0.f;
#pragma unroll
        for (int j = 0; j < 4; ++j) s += (v[q][j][0] * v[q][j][0] + v[q][j][1] * v[q][j][1]) + (v[q][j][2] * v[q][j][2] + v[q][j][3] * v[q][j][3]);
        s = wave_sum(s);
        u32x2* o8 = (u32x2*)(orow + (size_t)q * D_MODEL) + lane;
#pragma unroll
        for (int j = 0; j < 4; ++j) { u32x2 w; w.x = cvt_pk_bf16(v[q][j][0], v[q][j][1]); w.y = cvt_pk_bf16(v[q][j][2], v[q][j][3]); o8[64 * j] = w; }
        if (lane == 0) ss[q] = s; }
}
template <int NR> __device__ __forceinline__ void final_rows(float* xrow, const float* ss4, int row, const float* gain, int lane) {
    f32x4 v[NR][4]; float r[NR];
#pragma unroll
    for (int q = 0; q < NR; ++q) {
#pragma unroll
        for (int j = 0; j < 4; ++j) v[q][j] = ((const f32x4*)(xrow + (size_t)q * D_MODEL) + lane)[64 * j];
        r[q] = rsqrtf(((ss4[row + q] + ss4[MTOK + row + q]) + (ss4[2 * MTOK + row + q] + ss4[3 * MTOK + row + q])) * (1.f / D_MODEL) + EPS); }
    f32x4 g[4];
#pragma unroll
    for (int j = 0; j < 4; ++j) g[j] = ((const f32x4*)gain + lane)[64 * j];
#pragma unroll
    for (int q = 0; q < NR; ++q)
#pragma unroll
        for (int j = 0; j < 4; ++j) ((f32x4*)(xrow + (size_t)q * D_MODEL) + lane)[64 * j] = v[q][j] * r[q] * g[j];
}
}
#define RLX_AGENT __ATOMIC_RELAXED, __HIP_MEMORY_SCOPE_AGENT
#define XB_TMO      128
#define XB_XCNT(j)  (256  + 64 * (j))
#define XB_XSUB(j)  (1280 + 64 * (j))
#define XB_XGEN(j)  (2304 + 64 * (j))
#define XB_TOP      3328
#define XB_TOPGEN   3392
#define XCD_BAR_WORDS 3456
#define XB_SPIN_CAP (1u << 22)
__device__ __forceinline__ unsigned xb_ld(unsigned* p)              { return __hip_atomic_load(p, __ATOMIC_RELAXED, __HIP_MEMORY_SCOPE_AGENT); }
__device__ __forceinline__ unsigned xb_add(unsigned* p, unsigned v) { return __hip_atomic_fetch_add(p, v, __ATOMIC_RELAXED, __HIP_MEMORY_SCOPE_AGENT); }
__device__ __forceinline__ unsigned xb_xcc_id() { return (unsigned)__builtin_amdgcn_s_getreg((3 << 11) | 20) & 0xFu; }
#define XB_SPIN(cond, bar) do { unsigned _sp = 0; while (cond) { __builtin_amdgcn_s_sleep(1); \
    if ((++_sp & 255u) == 0u) { if (xb_ld(&(bar)[XB_TMO])) break; if (_sp > XB_SPIN_CAP) { atomicAdd(&(bar)[XB_TMO], 1u); break; } } } } while (0)
struct XcdBarrier { unsigned* bar; unsigned x; volatile LAS unsigned* st; };
__device__ __forceinline__ XcdBarrier xcd_barrier_post(unsigned* bar, volatile LAS unsigned* st) {
    XcdBarrier b; b.bar = bar; b.x = xb_xcc_id(); b.st = st;
    if (threadIdx.x == 0) (void)xb_add(&bar[XB_XCNT(b.x)], 1u);
    return b;
}
__device__ __forceinline__ void xcd_barrier_complete(unsigned* bar, unsigned x, unsigned& nloc, unsigned& nx) {
    const unsigned G = gridDim.x * gridDim.y * gridDim.z;
    unsigned sum, cnt, mine, sp = 0u;
    for (;;) {
        sum = 0u; cnt = 0u; mine = 0u;
#pragma unroll
        for (unsigned j = 0; j < 16; ++j) { const unsigned c = xb_ld(&bar[XB_XCNT(j)]); sum += c; cnt += (c > 0u) ? 1u : 0u; mine = (j == x) ? c : mine; }
        if (sum == G) break;
        __builtin_amdgcn_s_sleep(1);
        if ((++sp & 255u) == 0u) { if (xb_ld(&bar[XB_TMO])) break; if (sp > XB_SPIN_CAP) { atomicAdd(&bar[XB_TMO], 1u); break; } }
    }
    nloc = mine > 0u ? mine : 1u; nx = cnt > 0u ? cnt : 1u;
}
__device__ __forceinline__ void xcd_barrier(const XcdBarrier& b) {
    asm volatile("s_waitcnt vmcnt(0)" ::: "memory");
    __syncthreads();
    if (threadIdx.x == 0) {
        unsigned* bar = b.bar;
        __builtin_amdgcn_s_waitcnt(0);
        unsigned nloc = b.st[0], nx = b.st[1];
        if (nloc == 0u) { xcd_barrier_complete(bar, b.x, nloc, nx); b.st[0] = nloc; b.st[1] = nx; }
        const unsigned old = xb_add(&bar[XB_XSUB(b.x)], 1u);
        const unsigned gen = old / nloc;
        if (old + 1u == (gen + 1u) * nloc) {
            __builtin_amdgcn_fence(__ATOMIC_RELEASE, "agent");
            asm volatile("s_waitcnt vmcnt(0)" ::: "memory");
            const unsigned og = xb_add(&bar[XB_TOP], 1u);
            const unsigned tg = og / nx;
            if (og + 1u == (tg + 1u) * nx) xb_add(&bar[XB_TOPGEN], 1u);
            else XB_SPIN(xb_ld(&bar[XB_TOPGEN]) == tg, bar);
            __builtin_amdgcn_fence(__ATOMIC_ACQUIRE, "agent");
            xb_add(&bar[XB_XGEN(b.x)], 1u);
            asm volatile("s_waitcnt vmcnt(0)" ::: "memory");
        } else {
            XB_SPIN(xb_ld(&bar[XB_XGEN(b.x)]) == gen, bar);
            __builtin_amdgcn_fence(__ATOMIC_ACQUIRE, "agent");
            asm volatile("s_waitcnt vmcnt(0)" ::: "memory");
        }
    }
    __syncthreads();
}

constexpr int LDS_STAGE = 0;
constexpr int LDS_EPI = 131072;
constexpr int LDS_BIASTAB = 131072 + 4096;
constexpr int LDS_MISC = 131072 + 4096 + 1024;
constexpr int LDS_BYTES = 147456;
constexpr int NPHASE = 15;

struct Args { const float* in[26]; float* out; unsigned char* ws; int ph_lo, ph_hi; };
__device__ __forceinline__ int tid_now() { int t = threadIdx.x; asm volatile("" : "+v"(t)); return t; }
#define PHASE_IDS const int tid = tid_now(), lane = tid & 63, wave = __builtin_amdgcn_readfirstlane(tid >> 6), gw = c * 8 + wave, NGW = G * 8; LAS float* scr = (LAS float*)(lds + LDS_STAGE + wave * 16384); (void)lane; (void)gw; (void)NGW; (void)scr;

__global__ void __launch_bounds__(512, 2) mega_fwd(Args args) {
    extern __shared__ __attribute__((aligned(16))) unsigned char lds_raw[];
    LAS unsigned char* lds = (LAS unsigned char*)lds_raw;
    const int G = gridDim.x, c = blockIdx.x;
    unsigned char* ws = args.ws;
    const float* const* in = args.in;
    volatile LAS unsigned* MISC = (volatile LAS unsigned*)(lds + LDS_MISC);
    if (threadIdx.x < 64) MISC[threadIdx.x] = 0u;
    __syncthreads();
    const int lo = args.ph_lo, hi = args.ph_hi;
    const bool multi = (hi - lo) > 1;
    XcdBarrier bar; bar.bar = (unsigned*)(ws + WS_CTL); bar.x = 0; bar.st = nullptr;
    if (multi) bar = xcd_barrier_post((unsigned*)(ws + WS_CTL), MISC);
#define IN(k) (lo <= (k) && (k) < hi)
#ifdef PROBE_LO
    unsigned long long tstamp[NPHASE + 1]; const bool stamper = (c == 0 && threadIdx.x == 0);
    tstamp[0] = __builtin_amdgcn_s_memrealtime();
#if defined(PROBE_SUB)
#define SEAM(k) do { if (IN(k) && IN((k) + 1)) xcd_barrier(bar); } while (0)
#else
#define SEAM(k) do { if (IN(k) && IN((k) + 1)) xcd_barrier(bar); if ((k) + 1 == PROBE_LO) tstamp[0] = __builtin_amdgcn_s_memrealtime(); if ((k) == PROBE_HI) tstamp[1] = __builtin_amdgcn_s_memrealtime(); } while (0)
#endif
#else
#define SEAM(k) do { if (IN(k) && IN((k) + 1)) xcd_barrier(bar); } while (0)
#endif

    float* OUT = args.out;
    float* SS1 = (float*)(ws + WS_SS1); float* SS2 = (float*)(ws + WS_SS2); float* SS3 = (float*)(ws + WS_SS3); float* SS4 = (float*)(ws + WS_SS4); float* SSMEM = (float*)(ws + WS_SSM);
    bf16_t* MEMB = (bf16_t*)(ws + WS_MEMB); bf16_t* MEMKV = (bf16_t*)(ws + WS_MEMKV);
    bf16_t* WIN = (bf16_t*)(ws + WS_WIN); bf16_t* WGLU = (bf16_t*)(ws + WS_WGLU); bf16_t* WAU = (bf16_t*)(ws + WS_WAU); bf16_t* WKV = (bf16_t*)(ws + WS_WKV);
    bf16_t* WMU = (bf16_t*)(ws + WS_WMU); bf16_t* WOUT = (bf16_t*)(ws + WS_WOUT); bf16_t* WFIN = (bf16_t*)(ws + WS_WFIN); bf16_t* WFDN = (bf16_t*)(ws + WS_WFDN);
    bf16_t* XB = (bf16_t*)(ws + WS_XB); bf16_t* LP = (bf16_t*)(ws + WS_LP); bf16_t* QT = (bf16_t*)(ws + WS_QT); float* SLOC = (float*)(ws + WS_SLOC); float* LSE = (float*)(ws + WS_LSE);
    bf16_t* HB = (bf16_t*)(ws + WS_H); bf16_t* QKV = (bf16_t*)(ws + WS_QKV); bf16_t* XQ = (bf16_t*)(ws + WS_XQ); bf16_t* AG = (bf16_t*)(ws + WS_AG); bf16_t* GATE = (bf16_t*)(ws + WS_GATE);
    bf16_t* GATE_S = GATE; bf16_t* MERGED = GATE + (size_t)MTOK * D_MODEL; bf16_t* GATE_M = GATE + 2 * (size_t)MTOK * D_MODEL;

    if (IN(0)) { PHASE_IDS
        constexpr int I_FIN = 16 * 176, I_FDN = 44 * 32, I_WIN = 16 * 200, I_GLU = 8 * 64, I_AU = 4 * 32, I_KV = 16 * 32, I_MU = 8 * 32, I_OUT = 16 * 32;
        constexpr int NIT = I_FIN + I_FDN + I_WIN + I_GLU + I_AU + I_KV + I_MU + I_OUT;
        for (int it = gw; it < NIT; it += NGW) { int r = it;
            if (r < I_FIN) { prep::transpose_item(in[3], 1024, 5632, WFIN, 2816, in[2], scr, r, lane); continue; } r -= I_FIN;
            if (r < I_FDN) { prep::transpose_item(in[4], 2816, 1024, WFDN, 0, nullptr, scr, r, lane); continue; } r -= I_FDN;
            if (r < I_WIN) { prep::transpose_item(in[6], 1024, 6400, WIN, 0, in[5], scr, r, lane); continue; } r -= I_WIN;
            if (r < I_GLU) { prep::transpose_item(in[15], 512, 2048, WGLU, 1024, nullptr, scr, r, lane); continue; } r -= I_GLU;
            if (r < I_AU) { prep::transpose_item(in[17], 256, 1024, WAU, 0, nullptr, scr, r, lane); continue; } r -= I_AU;
            if (r < I_KV) { prep::transpose_item(in[19], 1024, 1024, WKV, 0, in[18], scr, r, lane); continue; } r -= I_KV;
            if (r < I_MU) { prep::transpose_item(in[20], 512, 1024, WMU, 0, nullptr, scr, r, lane); continue; } r -= I_MU;
            prep::transpose_item(in[21], 1024, 1024, WOUT, 0, nullptr, scr, r, lane);
        }
        for (int m = gw * 4; m < MTOK; m += NGW * 4) prep::rows_to_bf16<4>(in[0] + (size_t)m * D_MODEL, XB + (size_t)m * D_MODEL, SS1 + m, lane);
        att::build_bias(in[16], (float*)(ws + WS_BIAS), c * 512 + tid);
        for (int m = gw; m < MEMROWS; m += NGW) prep::rows_to_bf16<1>(in[1] + (size_t)m * D_MODEL, MEMB + (size_t)m * D_MODEL, SSMEM + m, lane);
    }
    SEAM(0);
    if (IN(1)) {
        g8::OrdDense S{(const char*)XB, (const char*)WFIN, 128, 22, 16, G, c, (size_t)256 * 1024 * 2, (size_t)256 * 1024 * 2};
        g8::EpiSwiglu E{HB, SS1, 1};
        g8::gemm_phase<g8::EpiSwiglu, g8::OrdDense, false>(lds, g8::Cfg{1024, 1024, (size_t)128 * 1024 * 2, (size_t)128 * 1024 * 2}, S, E);
    }
    SEAM(1);
    if (IN(2)) {
        g8::OrdDense S{(const char*)HB, (const char*)WFDN, 128, 4, 44, G, c, (size_t)256 * D_FF * 2, (size_t)256 * D_FF * 2};
        g8::EpiResid E{in[0], OUT, XB, SS2, 0.5f};
        g8::gemm_phase<g8::EpiResid, g8::OrdDense, false>(lds, g8::Cfg{D_FF, D_FF, (size_t)128 * D_FF * 2, (size_t)128 * D_FF * 2}, S, E);
    }
    SEAM(2);
    if (IN(3)) {
        g8::OrdProj S{(const char*)XB, (const char*)WIN, (const char*)MEMB, (const char*)WKV, G, c};
        g8::EpiProj E{SS2, SSMEM, AG, QKV, XQ, GATE, MEMKV};
        g8::gemm_phase<g8::EpiProj, g8::OrdProj, false>(lds, g8::Cfg{1024, 1024, (size_t)128 * 1024 * 2, (size_t)128 * 1024 * 2}, S, E);
    }
    SEAM(3);
    if (IN(4)) {
#if defined(PROBE_SUB)
#define SUBT(k) do { if (PROBE_SUB == (k)) tstamp[0] = __builtin_amdgcn_s_memrealtime(); if (PROBE_SUB + 1 == (k)) tstamp[1] = __builtin_amdgcn_s_memrealtime(); } while (0)
#else
#define SUBT(k) do { } while (0)
#endif
        SUBT(1);
        for (int it = c; it < 256; it += G) ssm::build_item(lds, it, in[7], in[8], in[9], in[10], in[11], in[12], in[13], in[14], LP, QT);
        SUBT(2);
        att::dattn_units(lds, QKV, LSE, (const float*)(ws + WS_BIAS), c, G);
        SUBT(3);
        for (int pi = c; pi < 256; pi += G) att::xattn_units(lds, XQ, MEMKV, pi >> 6, (pi >> 4) & 3, 2 * (pi & 15), 2);
        SUBT(4);
    }
    SEAM(4);
    if (IN(5)) { PHASE_IDS
        { g8::OrdSloc S{(const char*)AG, (const char*)QT, G, c}; g8::EpiSloc E{SLOC};
          g8::gemm_phase<g8::EpiSloc, g8::OrdSloc, false>(lds, g8::Cfg{AG_PITCH, 1024, (size_t)128 * AG_PITCH * 2, 0}, S, E); }
        att::combine_rows(QKV, LSE, gw, NGW);
        constexpr int I_FIN = 16 * 176, I_FDN = 44 * 32;
        for (int it = gw; it < I_FIN + I_FDN; it += NGW) {
            if (it < I_FIN) prep::transpose_item(in[23], 1024, 5632, WFIN, 2816, in[22], scr, it, lane);
            else prep::transpose_item(in[24], 2816, 1024, WFDN, 0, nullptr, scr, it - I_FIN, lane); }
    }
    SEAM(5);
    if (IN(6)) { if (c < 16) ssm::carry_scan(c * 512 + tid_now(), in[7], in[8], in[9], SLOC, AG); }
    SEAM(6);
    if (IN(7)) {
        g8::OrdY S{(const char*)AG, (const char*)LP, G, c}; g8::EpiY E{QKV + 768};
        g8::gemm_phase<g8::EpiY, g8::OrdY, true>(lds, g8::Cfg{AG_PITCH, LP_PITCH, (size_t)128 * AG_PITCH * 2, (size_t)128 * LP_PITCH * 2}, S, E);
    }
    SEAM(7);
    if (IN(8)) {
        g8::OrdDense S{(const char*)QKV, (const char*)WAU, 128, 4, 4, G, c, (size_t)256 * QKV_PITCH * 2, (size_t)256 * 256 * 2}; g8::EpiMerge<0> E{MERGED, MERGED};
        g8::gemm_phase<g8::EpiMerge<0>, g8::OrdDense, false>(lds, g8::Cfg{QKV_PITCH, 256, (size_t)128 * QKV_PITCH * 2, (size_t)128 * 256 * 2}, S, E);
    }
    SEAM(8);
    if (IN(9)) {
        g8::OrdDense S{(const char*)XQ, (const char*)WMU, 128, 4, 8, G, c, (size_t)256 * 512 * 2, (size_t)256 * 512 * 2}; g8::EpiMerge<1> E{GATE_M, MERGED};
        g8::gemm_phase<g8::EpiMerge<1>, g8::OrdDense, false>(lds, g8::Cfg{512, 512, (size_t)128 * 512 * 2, (size_t)128 * 512 * 2}, S, E);
    }
    SEAM(9);
    if (IN(10)) {
        g8::OrdDense S{(const char*)(QKV + 768), (const char*)WGLU, 128, 8, 8, G, c, (size_t)256 * QKV_PITCH * 2, (size_t)256 * 512 * 2}; g8::EpiMerge<2> E{GATE_S, MERGED};
        g8::gemm_phase<g8::EpiMerge<2>, g8::OrdDense, false>(lds, g8::Cfg{QKV_PITCH, 512, (size_t)128 * QKV_PITCH * 2, (size_t)128 * 512 * 2}, S, E);
    }
    SEAM(10);
    if (IN(11)) {
        g8::OrdDense S{(const char*)MERGED, (const char*)WOUT, 128, 4, 16, G, c, (size_t)256 * 1024 * 2, (size_t)256 * 1024 * 2}; g8::EpiResid E{OUT, OUT, XB, SS3, 1.0f};
        g8::gemm_phase<g8::EpiResid, g8::OrdDense, false>(lds, g8::Cfg{1024, 1024, (size_t)128 * 1024 * 2, (size_t)128 * 1024 * 2}, S, E);
    }
    SEAM(11);
    if (IN(12)) {
        g8::OrdDense S{(const char*)XB, (const char*)WFIN, 128, 22, 16, G, c, (size_t)256 * 1024 * 2, (size_t)256 * 1024 * 2}; g8::EpiSwiglu E{HB, SS3, 4};
        g8::gemm_phase<g8::EpiSwiglu, g8::OrdDense, false>(lds, g8::Cfg{1024, 1024, (size_t)128 * 1024 * 2, (size_t)128 * 1024 * 2}, S, E);
    }
    SEAM(12);
    if (IN(13)) {
        g8::OrdDense S{(const char*)HB, (const char*)WFDN, 128, 4, 44, G, c, (size_t)256 * D_FF * 2, (size_t)256 * D_FF * 2}; g8::EpiResid E{OUT, OUT, XB, SS4, 0.5f};
        g8::gemm_phase<g8::EpiResid, g8::OrdDense, false>(lds, g8::Cfg{D_FF, D_FF, (size_t)128 * D_FF * 2, (size_t)128 * D_FF * 2}, S, E);
    }
    SEAM(13);
    if (IN(14)) { PHASE_IDS for (int m = gw * 4; m < MTOK; m += NGW * 4) prep::final_rows<4>(OUT + (size_t)m * D_MODEL, SS4, m, in[25], lane); }
#ifdef PROBE_LO
    if (PROBE_HI == 14) { __syncthreads(); tstamp[1] = __builtin_amdgcn_s_memrealtime(); }
    if (stamper) { const unsigned long long want = (tstamp[1] - tstamp[0]) * PROBE_MULT, t1 = __builtin_amdgcn_s_memrealtime(); while (__builtin_amdgcn_s_memrealtime() - t1 < want) __builtin_amdgcn_s_sleep(8); }
#endif
#undef IN
#undef SEAM
}

#ifndef MK_MULTI
#define MK_MULTI 1
#endif
extern "C" void kernel_launch(void* const* d_in, const int* in_sizes, int n_in, void* d_out, int out_size, void* d_ws, size_t ws_size, hipStream_t stream) {
    static int grid = 0;
    if (!grid) {
        if (n_in != 26 || in_sizes[0] != MTOK * D_MODEL || out_size != MTOK * D_MODEL || ws_size < WS_END) { fprintf(stderr, "kernel_launch: unexpected problem: n_in %d, in0 %d, out %d, ws %zu (need %zu)\n", n_in, n_in > 0 ? in_sizes[0] : -1, out_size, ws_size, (size_t)WS_END); grid = -1; return; }
        if (hipFuncSetAttribute((const void*)mega_fwd, hipFuncAttributeMaxDynamicSharedMemorySize, LDS_BYTES) != hipSuccess) { fprintf(stderr, "kernel_launch: hipFuncSetAttribute failed\n"); grid = -1; return; }
        int dev = 0, cus = 0, per_cu = 0;
        if (hipGetDevice(&dev) != hipSuccess || hipDeviceGetAttribute(&cus, hipDeviceAttributeMultiprocessorCount, dev) != hipSuccess) { fprintf(stderr, "kernel_launch: device query failed\n"); grid = -1; return; }
        if (hipOccupancyMaxActiveBlocksPerMultiprocessor(&per_cu, (const void*)mega_fwd, 512, LDS_BYTES) != hipSuccess || per_cu < 1) { fprintf(stderr, "kernel_launch: occupancy query says %d blocks per CU\n", per_cu); grid = -1; return; }
        grid = cus;
        if (grid > 256) grid = 256;
        if (grid < 32) { fprintf(stderr, "kernel_launch: %d CUs is too few\n", cus); grid = -1; return; }
    }
    if (grid < 0) return;
    (void)hipMemsetAsync((char*)d_ws + WS_CTL, 0, 64 * 1024, stream);
    Args a{};
    for (int i = 0; i < 26; ++i) a.in[i] = (const float*)d_in[i];
    a.out = (float*)d_out; a.ws = (unsigned char*)d_ws;
#if MK_MULTI
    for (int p = 0; p < NPHASE; ++p) { a.ph_lo = p; a.ph_hi = p + 1; hipLaunchKernelGGL(mega_fwd, dim3(grid), dim3(512), LDS_BYTES, stream, a); }
#else
    a.ph_lo = 0; a.ph_hi = NPHASE;
    void* kargs[] = {&a};
    hipError_t e = hipLaunchCooperativeKernel((const void*)mega_fwd, dim3(grid), dim3(512), kargs, LDS_BYTES, stream);
    if (e != hipSuccess) fprintf(stderr, "kernel_launch: cooperative launch failed: %s (grid %d)\n", hipGetErrorString(e), grid);
#endif
}
```

```cpp
#include <hip/hip_runtime.h>
#include <cstdio>
#include <cstdint>
#include <cmath>
#define MK_MULTI 0
#define LAS __attribute__((address_space(3)))
#define GAS __attribute__((address_space(1)))
typedef unsigned short bf16_t;
typedef short bf16x8 __attribute__((ext_vector_type(8)));
typedef short s16x4 __attribute__((ext_vector_type(4)));
typedef float f32x4 __attribute__((ext_vector_type(4)));
typedef float f32x2 __attribute__((ext_vector_type(2)));
typedef float f32x16 __attribute__((ext_vector_type(16)));
typedef unsigned u32x4 __attribute__((ext_vector_type(4)));
typedef unsigned u32x2 __attribute__((ext_vector_type(2)));

constexpr int D_MODEL = 1024, NBATCH = 4, SEQ = 8192, MTOK = NBATCH * SEQ;
constexpr int D_FF = 2816, IN_WIDTH = 6400, MEM_LEN = 256, MEMROWS = NBATCH * MEM_LEN;
constexpr float EPS = 1e-6f;
constexpr float LOG2E = 1.4426950408889634f;

__device__ __forceinline__ unsigned cvt_pk_bf16(float lo, float hi) { unsigned r; asm volatile("v_cvt_pk_bf16_f32 %0, %1, %2" : "=v"(r) : "v"(lo), "v"(hi)); return r; }
__device__ __forceinline__ float bf_lo(unsigned w) { return __uint_as_float(w << 16); }
__device__ __forceinline__ float bf_hi(unsigned w) { return __uint_as_float(w & 0xffff0000u); }
__device__ __forceinline__ float fast_sigmoid(float v) { return __builtin_amdgcn_rcpf(1.f + __builtin_amdgcn_exp2f(-v * LOG2E)); }
__device__ __forceinline__ float gelu_tanh_f(float v) { const float z = 0.7978845608028654f * (v + 0.044715f * v * v * v); return v * __builtin_amdgcn_rcpf(1.f + __builtin_amdgcn_exp2f(-2.f * LOG2E * z)); }
__device__ __forceinline__ float wave_sum(float v) {
#pragma unroll
    for (int o = 1; o < 64; o <<= 1) v += __shfl_xor(v, o);
    return v;
}

constexpr size_t KiB = 1024;
constexpr size_t WS_CTL = 0;
constexpr size_t WS_SS1 = 64 * KiB;
constexpr size_t WS_SS2 = WS_SS1 + 128 * KiB;
constexpr size_t WS_SS3 = WS_SS2 + 512 * KiB;
constexpr size_t WS_SS4 = WS_SS3 + 512 * KiB;
constexpr size_t WS_SSM = WS_SS4 + 512 * KiB;
constexpr size_t WS_BIAS = WS_SSM + 4 * KiB;
constexpr size_t WS_MEMB = 1792 * KiB;
constexpr size_t WS_MEMKV = WS_MEMB + 2048 * KiB;
constexpr size_t WS_WIN = WS_MEMKV + 2048 * KiB;
constexpr size_t WS_WGLU = WS_WIN + 12800 * KiB;
constexpr size_t WS_WAU = WS_WGLU + 2048 * KiB;
constexpr size_t WS_WKV = WS_WAU + 512 * KiB;
constexpr size_t WS_WMU = WS_WKV + 2048 * KiB;
constexpr size_t WS_WOUT = WS_WMU + 1024 * KiB;
constexpr size_t WS_WFIN = WS_WOUT + 2048 * KiB;
constexpr size_t WS_WFDN = WS_WFIN + 11264 * KiB;
constexpr size_t WS_XB = WS_WFDN + 5632 * KiB;
constexpr size_t WS_LP = WS_XB;
constexpr size_t WS_QT = WS_LP + 24576 * KiB;
constexpr size_t WS_SLOC = WS_QT + 8192 * KiB;
constexpr size_t WS_LSE = WS_SLOC + 8192 * KiB;
constexpr size_t WS_BIG = WS_XB + 65536 * KiB;
constexpr size_t WS_H = WS_BIG;
constexpr size_t WS_QKV = WS_BIG;
constexpr size_t WS_XQ = WS_QKV + 147456 * KiB;
constexpr size_t WS_AG = WS_XQ + 32768 * KiB;
constexpr size_t WS_GATE = WS_AG + 36864 * KiB;
constexpr size_t WS_END = WS_GATE + 3 * 65536 * KiB;
static_assert(WS_BIAS + 12 * 192 * 4 <= WS_MEMB, "ws map");
static_assert(WS_LSE + 1536 * KiB <= WS_BIG, "ws map");
static_assert(WS_END <= (size_t)512 * 1024 * KiB, "ws map exceeds 512 MiB");
constexpr int QKV_PITCH = 2304, AG_PITCH = 1152, LP_PITCH = 1536;
namespace g8 {
constexpr int BM = 256, BK = 64, HALF = 128, HTB = HALF * BK * 2, STAGE_BYTES = 8 * HTB;

__host__ __device__ __forceinline__ int lds_byte(int r, int c) { const int st = (r >> 4) * 2 + (c >> 5), rr = r & 15, cc = c & 31, ob = rr * 64 + cc * 2; return st * 1024 + (ob ^ (((ob >> 9) & 1) << 5)); }
__host__ __device__ __forceinline__ void stage_rc(int b, int& R, int& C) { const int st = b / 1024, sb = b % 1024, swz = sb ^ (((sb >> 9) & 1) << 5); R = (st >> 1) * 16 + swz / 64; C = (st & 1) * 32 + (swz % 64) / 2; }
__host__ __device__ __forceinline__ int perm32(int rho) { const int n = rho >> 4, i = rho & 15; return 8 * (i >> 2) + 4 * n + (i & 3); }

struct Unit { const char* A; const char* B; int pm, pn, aux, nt, nt1, jumpA, jumpB; };
struct Cfg { int lda, ldb; size_t hstepA, hstepB; };

__device__ __forceinline__ void decode_tile(int L, int nM, int nN, int& pm, int& pn) {
    const int nwg = nM * nN; int wgid = L;
    { const int q = nwg / 8, r = nwg % 8, xcd = wgid % 8, off = wgid / 8; wgid = (xcd < r ? xcd * (q + 1) : r * (q + 1) + (xcd - r) * q) + off; }
    const int nig = 8 * nN, gid = wgid / nig, fm = gid * 8, gsz = (nM - fm) < 8 ? (nM - fm) : 8;
    pm = fm + ((wgid % nig) % gsz); pn = (wgid % nig) / gsz;
}

template <class Epi, class Sched, bool JUMP>
__device__ __forceinline__ void gemm_phase(LAS unsigned char* lds, const Cfg cfg, const Sched& S, const Epi& E) {
    const int tid = threadIdx.x, wid = __builtin_amdgcn_readfirstlane(tid >> 6), lane = tid & 63, wr = wid >> 2, wc = wid & 3, fr = lane & 15, fq = lane >> 4;
    unsigned voffA[2], voffB[2];
#pragma unroll
    for (int i = 0; i < 2; ++i) { int R, C; stage_rc(tid * 16 + i * 8192, R, C); const int Rb = Epi::PERM ? ((R & ~31) + perm32(R & 31)) : R;
        voffA[i] = (unsigned)(R * cfg.lda + C) * 2u; voffB[i] = (unsigned)(Rb * cfg.ldb + C) * 2u; }
    const size_t kstep = (size_t)(BK * 2);
    const size_t hsA = cfg.hstepA, hsB = cfg.hstepB;
    const unsigned ldsw = (unsigned)wid * 1024u;
    const int aoff = lds_byte(wr * 64 + fr, fq * 8), boff = lds_byte(wc * 32 + fr, fq * 8);
#define G8_SA(b, h) (((b) * 2 + (h)) * HTB)
#define G8_SB(b, h) ((4 + (b) * 2 + (h)) * HTB)
#define G8_STAGE(bufoff, gbase, voff) do { _Pragma("unroll") for (int _i = 0; _i < 2; ++_i) \
        __builtin_amdgcn_global_load_lds((const unsigned*)((const char*)(gbase) + (voff)[_i]), (LAS unsigned*)(lds + (bufoff) + ldsw + _i * 8192), 16, 0, 0); } while (0)
#define G8_LDA(dst, b, h) do { _Pragma("unroll") for (int m = 0; m < 4; ++m) _Pragma("unroll") for (int k = 0; k < 2; ++k) dst[m][k] = *(const LAS bf16x8*)(lds + G8_SA(b, h) + aoff + m * 2048 + k * 1024); } while (0)
#define G8_LDB(dst, b, h) do { _Pragma("unroll") for (int n = 0; n < 2; ++n) _Pragma("unroll") for (int k = 0; k < 2; ++k) dst[n][k] = *(const LAS bf16x8*)(lds + G8_SB(b, h) + boff + n * 2048 + k * 1024); } while (0)
#define G8_MMA(ai, bj, At, Bt) do { __builtin_amdgcn_s_setprio(1); _Pragma("unroll") for (int m = 0; m < 4; ++m) _Pragma("unroll") for (int n = 0; n < 2; ++n) _Pragma("unroll") for (int k = 0; k < 2; ++k) \
        acc[ai][bj][m][n] = __builtin_amdgcn_mfma_f32_16x16x32_bf16(Bt[n][k], At[m][k], acc[ai][bj][m][n], 0, 0, 0); __builtin_amdgcn_s_setprio(0); } while (0)
#define G8_WAIT_V(n) asm volatile("s_waitcnt vmcnt(" #n ")" ::: "memory")
#define G8_WAIT_L(n) asm volatile("s_waitcnt lgkmcnt(" #n ")" ::: "memory")
#define G8_BAR __builtin_amdgcn_s_barrier()
#define G8_SCHED __builtin_amdgcn_sched_barrier(0)
#define G8_KA(u, t) ((size_t)(t) * kstep + ((JUMP && (t) >= (u).nt1) ? (size_t)(long)(u).jumpA : (size_t)0))
#define G8_KB(u, t) ((size_t)(t) * kstep + ((JUMP && (t) >= (u).nt1) ? (size_t)(long)(u).jumpB : (size_t)0))
    Unit cur, nxt; int ui = 0;
    if (!S.next(0, cur)) return;
    f32x4 acc[2][2][4][2];
#pragma unroll
    for (int a = 0; a < 2; ++a)
#pragma unroll
        for (int b = 0; b < 2; ++b)
#pragma unroll
            for (int m = 0; m < 4; ++m)
#pragma unroll
                for (int n = 0; n < 2; ++n) acc[a][b][m][n] = (f32x4){0.f, 0.f, 0.f, 0.f};
    bf16x8 At[4][2], B0[2][2], B1[2][2];
    const char* cA = cur.A; const char* cB = cur.B;
    G8_STAGE(G8_SB(0, 0), cB, voffB); G8_STAGE(G8_SB(0, 1), cB + hsB, voffB); G8_STAGE(G8_SA(0, 0), cA, voffA); G8_STAGE(G8_SA(0, 1), cA + hsA, voffA);
    if (wr == 1) G8_BAR;
    G8_WAIT_V(2); G8_BAR;
    G8_STAGE(G8_SB(1, 0), cB + kstep, voffB); G8_STAGE(G8_SA(1, 0), cA + kstep, voffA); G8_STAGE(G8_SB(1, 1), cB + hsB + kstep, voffB);
    G8_WAIT_V(6); G8_BAR;
    for (;;) {
        const bool has_next = S.next(ui + 1, nxt);
        const char* nA = has_next ? nxt.A : cA; const char* nB = has_next ? nxt.B : cB;
        const int nt = cur.nt;
#ifdef PROBE_EPI
        const unsigned long long _tk0 = __builtin_amdgcn_s_memrealtime();
#endif
        for (int t = 0; t < nt; t += 2) {
            const bool last = (t == nt - 2);
            const char* a1 = cA + G8_KA(cur, t + 1);
            const char* a2 = last ? nA : cA + G8_KA(cur, t + 2); const char* b2 = last ? nB : cB + G8_KB(cur, t + 2);
            const char* a3 = last ? nA + kstep : cA + G8_KA(cur, t + 3); const char* b3 = last ? nB + kstep : cB + G8_KB(cur, t + 3);
            G8_LDB(B0, 0, 0); G8_LDB(B1, 0, 1); G8_SCHED; G8_LDA(At, 0, 0); G8_STAGE(G8_SA(1, 1), a1 + hsA, voffA);
            G8_WAIT_V(8); G8_WAIT_L(0); G8_BAR; G8_MMA(0, 0, At, B0); G8_MMA(0, 1, At, B1); G8_BAR; G8_SCHED;
            G8_LDA(At, 0, 1); G8_STAGE(G8_SB(0, 0), b2, voffB); G8_STAGE(G8_SB(0, 1), b2 + hsB, voffB); G8_STAGE(G8_SA(0, 0), a2, voffA);
            G8_WAIT_V(8); G8_WAIT_L(0); G8_BAR; G8_MMA(1, 0, At, B0); G8_MMA(1, 1, At, B1); G8_BAR; G8_SCHED;
            G8_LDB(B0, 1, 0); G8_LDB(B1, 1, 1); G8_SCHED; G8_LDA(At, 1, 0); G8_STAGE(G8_SA(0, 1), a2 + hsA, voffA);
            G8_WAIT_V(8); G8_WAIT_L(0); G8_BAR; G8_MMA(0, 0, At, B0); G8_MMA(0, 1, At, B1); G8_BAR; G8_SCHED;
            G8_LDA(At, 1, 1); G8_STAGE(G8_SB(1, 0), b3, voffB); G8_STAGE(G8_SB(1, 1), b3 + hsB, voffB); G8_STAGE(G8_SA(1, 0), a3, voffA);
            G8_WAIT_V(8); G8_WAIT_L(0); G8_BAR; G8_MMA(1, 0, At, B0); G8_MMA(1, 1, At, B1); G8_BAR; G8_SCHED;
        }
#ifdef PROBE_EPI
        const unsigned long long _tk1 = __builtin_amdgcn_s_memrealtime();
#endif
        if (wr == 0) G8_BAR;
#ifdef PROBE_EPI
        const unsigned long long _te0 = __builtin_amdgcn_s_memrealtime();
#endif
        E(acc, cur, wr, wc, fr, fq, lds);
#ifdef PROBE_EPI
        { const unsigned long long _te1 = __builtin_amdgcn_s_memrealtime(); volatile LAS unsigned* _pm = (volatile LAS unsigned*)(lds + 131072 + 4096 + 1024);
          if (tid == 0 && _pm[17]) { if (PROBE_EPI == 1) _pm[16] += (unsigned)(_tk1 - _tk0); if (PROBE_EPI == 2) _pm[16] += (unsigned)(_te0 - _tk1); if (PROBE_EPI == 3) _pm[16] += (unsigned)(_te1 - _te0); } }
#endif
        if (!has_next) break;
#pragma unroll
        for (int a = 0; a < 2; ++a)
#pragma unroll
            for (int b = 0; b < 2; ++b)
#pragma unroll
                for (int m = 0; m < 4; ++m)
#pragma unroll
                    for (int n = 0; n < 2; ++n) acc[a][b][m][n] = (f32x4){0.f, 0.f, 0.f, 0.f};
        cur = nxt; cA = nA; cB = nB; ++ui;
        if (wr == 1) G8_BAR;
    }
    G8_WAIT_V(0);
    G8_BAR;
#undef G8_SA
#undef G8_SB
#undef G8_STAGE
#undef G8_LDA
#undef G8_LDB
#undef G8_MMA
#undef G8_WAIT_V
#undef G8_WAIT_L
#undef G8_BAR
#undef G8_SCHED
#undef G8_KA
#undef G8_KB
}
}
namespace g8 {
constexpr int EPI_SCR = STAGE_BYTES;

__device__ __forceinline__ float row_rstd(const float* ss, int nparts, int stride, int row) {
    float s = ss[row];
    for (int i = 1; i < nparts; ++i) s += ss[(size_t)i * stride + row];
    return rsqrtf(s * (1.f / D_MODEL) + EPS);
}

struct EpiSwiglu {
    static constexpr bool PERM = true;
    bf16_t* H; const float* ss; int nparts;
    __device__ __forceinline__ void operator()(const f32x4 (&acc)[2][2][4][2], const Unit& u, int wr, int wc, int fr, int fq, LAS unsigned char*) const {
        float rs[2][4];
#pragma unroll
        for (int ai = 0; ai < 2; ++ai)
#pragma unroll
            for (int m = 0; m < 4; ++m) { const int row = u.pm * BM + ai * HALF + wr * 64 + m * 16 + fr; float sv = ss[row]; if (nparts == 4) sv = (sv + ss[MTOK + row]) + (ss[2 * MTOK + row] + ss[3 * MTOK + row]); rs[ai][m] = sv; }
#pragma unroll
        for (int ai = 0; ai < 2; ++ai)
#pragma unroll
            for (int m = 0; m < 4; ++m) {
                const int row = u.pm * BM + ai * HALF + wr * 64 + m * 16 + fr;
                const float r = rsqrtf(rs[ai][m] * (1.f / D_MODEL) + EPS);
                float hv[8];
#pragma unroll
                for (int n = 0; n < 2; ++n)
#pragma unroll
                    for (int j = 0; j < 4; ++j) { const float a = acc[ai][0][m][n][j] * r, b = acc[ai][1][m][n][j] * r; hv[n * 4 + j] = a * fast_sigmoid(a) * b; }
                u32x4 w; w.x = cvt_pk_bf16(hv[0], hv[1]); w.y = cvt_pk_bf16(hv[2], hv[3]); w.z = cvt_pk_bf16(hv[4], hv[5]); w.w = cvt_pk_bf16(hv[6], hv[7]);
                *(u32x4*)(H + (size_t)row * D_FF + u.pn * 128 + wc * 32 + fq * 8) = w;
            }
    }
};

struct EpiResid {
    static constexpr bool PERM = false;
    const float* xres; float* xout; bf16_t* xb; float* ssout; float alpha;
    __device__ __forceinline__ void operator()(const f32x4 (&acc)[2][2][4][2], const Unit& u, int wr, int wc, int fr, int fq, LAS unsigned char* lds) const {
        LAS float* scr = (LAS float*)(lds + EPI_SCR);
#pragma unroll
        for (int ai = 0; ai < 2; ++ai) {
            f32x4 xr[4][2][2];
#pragma unroll
            for (int m = 0; m < 4; ++m)
#pragma unroll
                for (int bj = 0; bj < 2; ++bj)
#pragma unroll
                    for (int n = 0; n < 2; ++n) xr[m][bj][n] = *(const f32x4*)(xres + ((size_t)u.pm * BM + ai * HALF + wr * 64 + m * 16 + fr) * D_MODEL + u.pn * BM + bj * HALF + wc * 32 + n * 16 + fq * 4);
#pragma unroll
            for (int m = 0; m < 4; ++m) {
                const int lrow = ai * HALF + wr * 64 + m * 16 + fr; const size_t row = (size_t)u.pm * BM + lrow;
                float sq = 0.f;
#pragma unroll
                for (int bj = 0; bj < 2; ++bj)
#pragma unroll
                    for (int n = 0; n < 2; ++n) {
                        const size_t off = row * D_MODEL + u.pn * BM + bj * HALF + wc * 32 + n * 16 + fq * 4;
                        f32x4 o = xr[m][bj][n] + acc[ai][bj][m][n] * alpha;
                        *(f32x4*)(xout + off) = o; sq += (o[0] * o[0] + o[1] * o[1]) + (o[2] * o[2] + o[3] * o[3]);
                        u32x2 w; w.x = cvt_pk_bf16(o[0], o[1]); w.y = cvt_pk_bf16(o[2], o[3]); *(u32x2*)(xb + off) = w;
                    }
                sq += __shfl_xor(sq, 16); sq += __shfl_xor(sq, 32);
                if (fq == 0) scr[lrow * 4 + wc] = sq;
            }
        }
        asm volatile("s_waitcnt lgkmcnt(0)" ::: "memory"); __builtin_amdgcn_s_barrier(); asm volatile("" ::: "memory");
        if (threadIdx.x < 256) { const int lrow = threadIdx.x; const f32x4 p = *(const LAS f32x4*)(scr + lrow * 4);
            ssout[(size_t)u.pn * MTOK + (size_t)u.pm * BM + lrow] = (p[0] + p[1]) + (p[2] + p[3]); }
        asm volatile("s_waitcnt lgkmcnt(0)" ::: "memory"); __builtin_amdgcn_s_barrier(); asm volatile("" ::: "memory");
    }
};

struct EpiProj {
    static constexpr bool PERM = true;
    const float* ss2; const float* ssm; bf16_t *AG, *QKV, *XQ, *GATE, *MEMKV;
    __device__ __forceinline__ void operator()(const f32x4 (&acc)[2][2][4][2], const Unit& u, int wr, int wc, int fr, int fq, LAS unsigned char*) const {
        const int pn = u.pn; const bool is_mem = (u.aux != 0);
        int kind; bf16_t* dst; int pitch; float scale = 1.f;
        if (is_mem) { kind = 0; dst = MEMKV + pn * 256; pitch = 1024; }
        else if (pn < 2) { kind = 2; dst = AG; pitch = 0; }
        else if (pn < 11) { kind = 0; dst = QKV + (pn - 2) * 256; pitch = QKV_PITCH; if (pn < 5) scale = 0.125f * LOG2E; }
        else if (pn < 13) { kind = 0; dst = XQ + (pn - 11) * 256; pitch = 512; scale = 0.08838834764831845f * LOG2E; }
        else { kind = 1; const int gi = (pn - 13) >> 2; dst = GATE + (size_t)gi * MTOK * D_MODEL + ((pn - 13) & 3) * 256; pitch = 1024; }
        float rs[2][4];
#pragma unroll
        for (int ai = 0; ai < 2; ++ai)
#pragma unroll
            for (int m = 0; m < 4; ++m) { const int row = u.pm * BM + ai * HALF + wr * 64 + m * 16 + fr; rs[ai][m] = is_mem ? ssm[row] : (ss2[row] + ss2[MTOK + row]) + (ss2[2 * MTOK + row] + ss2[3 * MTOK + row]); }
#pragma unroll
        for (int ai = 0; ai < 2; ++ai)
#pragma unroll
            for (int m = 0; m < 4; ++m) {
                const int row = u.pm * BM + ai * HALF + wr * 64 + m * 16 + fr;
                const float r = rsqrtf(rs[ai][m] * (1.f / D_MODEL) + EPS) * scale;
#pragma unroll
                for (int bj = 0; bj < 2; ++bj) {
                    float v[8];
#pragma unroll
                    for (int n = 0; n < 2; ++n)
#pragma unroll
                        for (int j = 0; j < 4; ++j) { float x = acc[ai][bj][m][n][j] * r; if (kind == 1) x = fast_sigmoid(x); v[n * 4 + j] = x; }
                    u32x4 w; w.x = cvt_pk_bf16(v[0], v[1]); w.y = cvt_pk_bf16(v[2], v[3]); w.z = cvt_pk_bf16(v[4], v[5]); w.w = cvt_pk_bf16(v[6], v[7]);
                    const int col = bj * HALF + wc * 32 + fq * 8;
                    bf16_t* p;
                    if (kind == 2) { const int ch = pn * 256 + col, g = ch >> 4, h0 = ch & 15; const int b = row >> 13, l = row & 8191, c = l >> 6, t = l & 63;
                        p = AG + ((size_t)(g * 512 + b * 128 + c) * AG_PITCH + t * 16 + h0); }
                    else p = dst + (size_t)row * pitch + col;
                    *(u32x4*)p = w;
                }
            }
    }
};

struct EpiSloc {
    static constexpr bool PERM = false;
    float* SLOC;
    __device__ __forceinline__ void operator()(const f32x4 (&acc)[2][2][4][2], const Unit& u, int wr, int wc, int fr, int fq, LAS unsigned char*) const {
#pragma unroll
        for (int ai = 0; ai < 2; ++ai)
#pragma unroll
            for (int m = 0; m < 4; ++m) {
                const int row = u.pm * BM + ai * HALF + wr * 64 + m * 16 + fr;
#pragma unroll
                for (int n = 0; n < 2; ++n) *(f32x4*)(SLOC + (size_t)row * 128 + wc * 32 + n * 16 + fq * 4) = acc[ai][0][m][n];
            }
    }
};

struct EpiY {
    static constexpr bool PERM = true;
    bf16_t* Y;
    __device__ __forceinline__ void operator()(const f32x4 (&acc)[2][2][4][2], const Unit& u, int wr, int wc, int fr, int fq, LAS unsigned char*) const {
        const int g = u.pm >> 1, rt = u.pm & 1, j = u.pn;
#pragma unroll
        for (int ai = 0; ai < 2; ++ai)
#pragma unroll
            for (int m = 0; m < 4; ++m) {
                const int r = rt * 256 + ai * HALF + wr * 64 + m * 16 + fr; const int b = r >> 7, c = r & 127;
#pragma unroll
                for (int bj = 0; bj < 2; ++bj) {
                    const int col = bj * HALF + wc * 32 + fq * 8, tl = col >> 4, h0 = col & 15; const int tok = b * SEQ + c * 64 + j * 16 + tl;
                    float v[8];
#pragma unroll
                    for (int n = 0; n < 2; ++n)
#pragma unroll
                        for (int q = 0; q < 4; ++q) v[n * 4 + q] = gelu_tanh_f(acc[ai][bj][m][n][q]);
                    u32x4 w; w.x = cvt_pk_bf16(v[0], v[1]); w.y = cvt_pk_bf16(v[2], v[3]); w.z = cvt_pk_bf16(v[4], v[5]); w.w = cvt_pk_bf16(v[6], v[7]);
                    *(u32x4*)(Y + (size_t)tok * QKV_PITCH + g * 16 + h0) = w;
                }
            }
    }
};

template <int MODE> struct EpiMerge {
    static constexpr bool PERM = true;
    const bf16_t* gate; bf16_t* merged;
    __device__ __forceinline__ void operator()(const f32x4 (&acc)[2][2][4][2], const Unit& u, int wr, int wc, int fr, int fq, LAS unsigned char*) const {
        constexpr int NBJ = (MODE == 2) ? 1 : 2;
#pragma unroll
        for (int ai = 0; ai < 2; ++ai) {
            u32x4 gw[4][NBJ], mw[4][NBJ];
#pragma unroll
            for (int m = 0; m < 4; ++m)
#pragma unroll
                for (int bj = 0; bj < NBJ; ++bj) { const size_t off = ((size_t)u.pm * BM + ai * HALF + wr * 64 + m * 16 + fr) * D_MODEL + (MODE == 2 ? u.pn * 128 : u.pn * BM + bj * HALF) + wc * 32 + fq * 8;
                    gw[m][bj] = *(const u32x4*)(gate + off); if (MODE != 0) mw[m][bj] = *(const u32x4*)(merged + off); else mw[m][bj] = (u32x4){0u, 0u, 0u, 0u}; }
#pragma unroll
            for (int m = 0; m < 4; ++m)
#pragma unroll
                for (int bj = 0; bj < NBJ; ++bj) {
                    const size_t off = ((size_t)u.pm * BM + ai * HALF + wr * 64 + m * 16 + fr) * D_MODEL + (MODE == 2 ? u.pn * 128 : u.pn * BM + bj * HALF) + wc * 32 + fq * 8;
                    float v[8];
#pragma unroll
                    for (int n = 0; n < 2; ++n)
#pragma unroll
                        for (int q = 0; q < 4; ++q) v[n * 4 + q] = (MODE == 2) ? acc[ai][0][m][n][q] * fast_sigmoid(acc[ai][1][m][n][q]) : acc[ai][bj][m][n][q];
                    float o[8];
#pragma unroll
                    for (int q = 0; q < 4; ++q) { o[2 * q] = bf_lo(gw[m][bj][q]) * v[2 * q]; o[2 * q + 1] = bf_hi(gw[m][bj][q]) * v[2 * q + 1]; }
                    if (MODE != 0) {
#pragma unroll
                        for (int q = 0; q < 4; ++q) { o[2 * q] += bf_lo(mw[m][bj][q]); o[2 * q + 1] += bf_hi(mw[m][bj][q]); } }
                    u32x4 w; w.x = cvt_pk_bf16(o[0], o[1]); w.y = cvt_pk_bf16(o[2], o[3]); w.z = cvt_pk_bf16(o[4], o[5]); w.w = cvt_pk_bf16(o[6], o[7]);
                    *(u32x4*)(merged + off) = w;
                }
        }
    }
};

struct OrdDense {
    const char* A; const char* B; int nM, nN, nt, G, c; size_t tstepA, tstepB;
    __device__ __forceinline__ bool next(int i, Unit& u) const {
        const long L = (long)i * G + c; if (L >= (long)nM * nN) return false;
        decode_tile((int)L, nM, nN, u.pm, u.pn); u.A = A + (size_t)u.pm * tstepA; u.B = B + (size_t)u.pn * tstepB; u.aux = 0; u.nt = nt; u.nt1 = nt; u.jumpA = 0; u.jumpB = 0; return true;
    }
};
struct OrdProj {
    const char *A, *B, *Am, *Bm; int G, c;
    __device__ __forceinline__ bool next(int i, Unit& u) const {
        const long L = (long)i * G + c; u.nt = 16; u.nt1 = 16; u.jumpA = 0; u.jumpB = 0;
        if (L < 3200) { decode_tile((int)L, 128, 25, u.pm, u.pn); u.A = A + (size_t)u.pm * (256 * 1024 * 2); u.B = B + (size_t)u.pn * (256 * 1024 * 2); u.aux = 0; return true; }
        if (L < 3216) { const int x = (int)L - 3200; u.pm = x >> 2; u.pn = x & 3; u.A = Am + (size_t)u.pm * (256 * 1024 * 2); u.B = Bm + (size_t)u.pn * (256 * 1024 * 2); u.aux = 1; return true; }
        return false;
    }
};
struct OrdSloc {
    const char *AG, *QT; int G, c;
    __device__ __forceinline__ bool next(int i, Unit& u) const {
        const long L = (long)i * G + c; if (L >= 64) return false;
        u.pm = (int)L; u.pn = 0; u.A = AG + (size_t)u.pm * (256 * AG_PITCH * 2); u.B = QT + (size_t)(u.pm >> 1) * (128 * 1024 * 2); u.aux = 0; u.nt = 16; u.nt1 = 16; u.jumpA = 0; u.jumpB = 0; return true;
    }
};
struct OrdY {
    const char *AG, *LP; int G, c;
    __device__ __forceinline__ bool next(int i, Unit& u) const {
        const long L = (long)i * G + c; if (L >= 256) return false;
        const int j = 3 - (int)(L >> 6), pm = (int)(L & 63);
        u.pm = pm; u.pn = j; u.aux = 0; u.A = AG + (size_t)pm * (256 * AG_PITCH * 2); u.B = LP + (size_t)(pm >> 1) * (256 * LP_PITCH * 2) + (size_t)(48 - 16 * j) * 16 * 2;
        u.nt1 = 4 * (j + 1); u.nt = u.nt1 + 2; u.jumpA = (1024 - 256 * (j + 1)) * 2; u.jumpB = (1024 + 128 * j - ((48 - 16 * j) * 16 + 256 * (j + 1))) * 2; return true;
    }
};
}
namespace att {
__device__ __forceinline__ int tid_opaque() { int t = threadIdx.x; asm volatile("" : "+v"(t)); return t; }
__device__ __forceinline__ int crow(int r, int hi) { return (r & 3) + 8 * (r >> 2) + 4 * hi; }
__device__ __forceinline__ s16x4 vtr(const LAS char* p) { typedef short v4i16_t __attribute__((ext_vector_type(4))); return __builtin_bit_cast(s16x4, __builtin_amdgcn_ds_read_tr16_b64_v4i16((LAS v4i16_t*)p)); }

template <int D> __device__ __forceinline__ f32x16 qk_tile(const LAS char* Kl, int krow, const bf16x8 (&qf)[D / 16], int hh) {
    const LAS char* kp = Kl + krow * (D * 2); const int sw = krow & 7; f32x16 s = {};
#pragma unroll
    for (int d0 = 0; d0 < D / 16; ++d0) { const bf16x8 kf = *(const LAS bf16x8*)(kp + (((2 * d0 + hh) ^ sw) << 4)); s = __builtin_amdgcn_mfma_f32_32x32x16_bf16(kf, qf[d0], s, 0, 0, 0); }
    return s;
}
template <int D> __device__ __forceinline__ void pv_tile(f32x16 (&o)[D / 32], const LAS char* vb, bf16x8 pb0, bf16x8 pb1) {
    constexpr int RB = D * 2;
#pragma unroll
    for (int db = 0; db < D / 32; ++db) {
        const s16x4 a0 = vtr(vb + db * 64), a1 = vtr(vb + db * 64 + 8 * RB), a2 = vtr(vb + db * 64 + 16 * RB), a3 = vtr(vb + db * 64 + 24 * RB);
        const bf16x8 v0 = (bf16x8){a0[0], a0[1], a0[2], a0[3], a1[0], a1[1], a1[2], a1[3]}, v1 = (bf16x8){a2[0], a2[1], a2[2], a2[3], a3[0], a3[1], a3[2], a3[3]};
        o[db] = __builtin_amdgcn_mfma_f32_32x32x16_bf16(v0, pb0, o[db], 0, 0, 0);
        o[db] = __builtin_amdgcn_mfma_f32_32x32x16_bf16(v1, pb1, o[db], 0, 0, 0);
    }
}
__device__ __forceinline__ void pack_p(const f32x16& p, bf16x8& pb0, bf16x8& pb1) {
    u32x4 w0, w1;
    w0.x = cvt_pk_bf16(p[0], p[1]); w0.y = cvt_pk_bf16(p[2], p[3]); w0.z = cvt_pk_bf16(p[4], p[5]); w0.w = cvt_pk_bf16(p[6], p[7]);
    w1.x = cvt_pk_bf16(p[8], p[9]); w1.y = cvt_pk_bf16(p[10], p[11]); w1.z = cvt_pk_bf16(p[12], p[13]); w1.w = cvt_pk_bf16(p[14], p[15]);
    pb0 = __builtin_bit_cast(bf16x8, w0); pb1 = __builtin_bit_cast(bf16x8, w1);
}
__device__ __forceinline__ float max16(const f32x16& s) {
    float a = fmaxf(fmaxf(s[0], s[1]), fmaxf(s[2], s[3])), b = fmaxf(fmaxf(s[4], s[5]), fmaxf(s[6], s[7])), c = fmaxf(fmaxf(s[8], s[9]), fmaxf(s[10], s[11])), d = fmaxf(fmaxf(s[12], s[13]), fmaxf(s[14], s[15]));
    return fmaxf(fmaxf(a, b), fmaxf(c, d));
}

__device__ __forceinline__ void dattn_wave(int lane, const LAS char* Kl, const LAS char* Vl, int krow0, const bf16x8 (&qf)[4], const LAS float* biasL, int first_ok, f32x16 (&o)[2], float& m_out, float& l_out) {
    const int r = lane & 31, hh = lane >> 5;
    f32x16 s[5];
#pragma unroll
    for (int kt = 0; kt < 5; ++kt) s[kt] = qk_tile<64>(Kl, krow0 + 32 * kt + r, qf, hh);
    __builtin_amdgcn_sched_barrier(0);
    float m = -INFINITY;
    const LAS float* bbase = biasL + (r - 4 * hh + 1);
#pragma unroll
    for (int kt = 0; kt < 5; ++kt) {
        const bool tile_ok = kt >= first_ok;
        float bb[16];
#pragma unroll
        for (int rg = 0; rg < 16; ++rg) bb[rg] = bbase[159 - 32 * kt - (rg & 3) - 8 * (rg >> 2)];
        asm volatile("" : "+v"(bb[0]), "+v"(bb[1]), "+v"(bb[2]), "+v"(bb[3]), "+v"(bb[4]), "+v"(bb[5]), "+v"(bb[6]), "+v"(bb[7]), "+v"(bb[8]), "+v"(bb[9]), "+v"(bb[10]), "+v"(bb[11]), "+v"(bb[12]), "+v"(bb[13]), "+v"(bb[14]), "+v"(bb[15]));
#pragma unroll
        for (int rg = 0; rg < 16; ++rg) { const int kl = crow(rg, hh);
            bool ok = tile_ok; if (kt == 0) ok = ok && (kl >= r); if (kt == 4) ok = ok && (kl <= r);
            const float v = s[kt][rg] + bb[rg]; s[kt][rg] = ok ? v : -INFINITY; }
        m = fmaxf(m, max16(s[kt]));
        __builtin_amdgcn_sched_barrier(0);
    }
    m = fmaxf(m, __shfl_xor(m, 32));
    float l = 0.f;
    o[0] = f32x16{}; o[1] = f32x16{};
    const int gi = lane >> 4, li = lane & 15;
    const LAS char* vb0 = Vl + (krow0 + 4 * (gi >> 1) + (li >> 2)) * 128 + (16 * (gi & 1) + 4 * (li & 3)) * 2;
#pragma unroll
    for (int kt = 0; kt < 5; ++kt) {
        float ps = 0.f;
#pragma unroll
        for (int rg = 0; rg < 16; ++rg) { s[kt][rg] = __builtin_amdgcn_exp2f(s[kt][rg] - m); ps += s[kt][rg]; }
        l += ps;
        bf16x8 pb0, pb1; pack_p(s[kt], pb0, pb1);
        pv_tile<64>(o, vb0 + kt * 32 * 128, pb0, pb1);
    }
    l += __shfl_xor(l, 32);
    m_out = m; l_out = l;
}

__device__ __forceinline__ void xattn_wave(int lane, const LAS char* Kl, const LAS char* Vl, const bf16x8 (&qf)[8], f32x16 (&o)[4], float& l_out) {
    const int r = lane & 31, hh = lane >> 5;
    const int gi = lane >> 4, li = lane & 15;
    const LAS char* vb0 = Vl + (4 * (gi >> 1) + (li >> 2)) * 256 + (16 * (gi & 1) + 4 * (li & 3)) * 2;
    float m = 0.f, l = 0.f;
#pragma unroll
    for (int db = 0; db < 4; ++db) o[db] = f32x16{};
#pragma unroll
    for (int ck = 0; ck < 4; ++ck) {
        f32x16 s[2];
#pragma unroll
        for (int t = 0; t < 2; ++t) s[t] = qk_tile<128>(Kl, 32 * (2 * ck + t) + r, qf, hh);
        float tm = fmaxf(max16(s[0]), max16(s[1]));
        tm = fmaxf(tm, __shfl_xor(tm, 32));
        if (ck == 0) m = tm;
        else { const float mn = fmaxf(m, tm), sc = __builtin_amdgcn_exp2f(m - mn); m = mn; l *= sc;
#pragma unroll
            for (int db = 0; db < 4; ++db) o[db] = o[db] * sc; }
#pragma unroll
        for (int t = 0; t < 2; ++t) {
            float ps = 0.f;
#pragma unroll
            for (int rg = 0; rg < 16; ++rg) { s[t][rg] = __builtin_amdgcn_exp2f(s[t][rg] - m); ps += s[t][rg]; }
            l += ps;
            bf16x8 pb0, pb1; pack_p(s[t], pb0, pb1);
            pv_tile<128>(o, vb0 + (2 * ck + t) * 32 * 256, pb0, pb1);
        }
    }
    l += __shfl_xor(l, 32);
    l_out = l;
}

template <int D> __device__ __forceinline__ void store_o(int hh, bf16_t* orow, const f32x16 (&o)[D / 32], float inv_l) {
#pragma unroll
    for (int db = 0; db < D / 32; ++db)
#pragma unroll
        for (int q4 = 0; q4 < 4; ++q4) { u32x2 w; w.x = cvt_pk_bf16(o[db][4 * q4] * inv_l, o[db][4 * q4 + 1] * inv_l); w.y = cvt_pk_bf16(o[db][4 * q4 + 2] * inv_l, o[db][4 * q4 + 3] * inv_l);
            *(u32x2*)(orow + 32 * db + 8 * q4 + 4 * hh) = w; }
}

__device__ const unsigned char BUCKETS[3][129] = {
{0,1,2,3,4,5,6,7,8,9,10,11,12,13,14,15,16,16,16,16,16,16,17,17,17,17,17,17,17,17,18,18,18,18,18,18,18,18,18,18,19,19,19,19,19,19,19,19,19,19,19,19,19,19,20,20,20,20,20,20,20,20,20,20,20,20,20,20,20,20,20,20,20,21,21,21,21,21,21,21,21,21,21,21,21,21,21,21,21,21,21,21,21,21,21,21,21,21,21,22,22,22,22,22,22,22,22,22,22,22,22,22,22,22,22,22,22,22,22,22,22,22,22,22,22,22,22,22,22},
{0,4,8,12,16,16,17,17,18,18,19,19,19,19,20,20,20,20,20,21,21,21,21,21,21,22,22,22,22,22,22,22,22,22,23,23,23,23,23,23,23,23,23,23,23,23,24,24,24,24,24,24,24,24,24,24,24,24,24,24,24,24,25,25,25,25,25,25,25,25,25,25,25,25,25,25,25,25,25,25,25,25,25,26,26,26,26,26,26,26,26,26,26,26,26,26,26,26,26,26,26,26,26,26,26,26,26,26,26,26,26,26,26,27,27,27,27,27,27,27,27,27,27,27,27,27,27,27,27},
{0,16,18,19,20,21,21,22,22,23,23,23,24,24,24,24,25,25,25,25,25,26,26,26,26,26,26,26,26,27,27,27,27,27,27,27,27,27,27,28,28,28,28,28,28,28,28,28,28,28,28,28,29,29,29,29,29,29,29,29,29,29,29,29,29,29,29,29,29,29,30,30,30,30,30,30,30,30,30,30,30,30,30,30,30,30,30,30,30,30,30,30,30,30,30,31,31,31,31,31,31,31,31,31,31,31,31,31,31,31,31,31,31,31,31,31,31,31,31,31,31,31,31,31,31,31,31,31,31}};

__device__ __forceinline__ void build_bias(const float* rel, float* tab, int idx) {
    if (idx >= 12 * 192) return; const int gh = idx / 192, i = idx % 192, g = gh >> 2, j = i - 32;
    tab[idx] = (j >= 0 && j <= 128) ? rel[(int)BUCKETS[g][j] * 12 + gh] * LOG2E : 0.f;
}
constexpr int LDS_K = 0, LDS_V = 65536, LDS_BIAS = 131072 + 4096;

struct DUnit { int b, g, h, rs, qt, dil; };
__device__ __forceinline__ DUnit dunit(int u) { DUnit d; const int x = u & 31, rest = u >> 7; d.h = (u >> 5) & 3; d.g = rest % 3; d.b = rest / 3; const int ntile = (d.g == 0) ? 32 : (d.g == 1 ? 8 : 2);
    d.rs = x / ntile; d.qt = x % ntile; d.dil = (d.g == 0) ? 1 : (d.g == 1 ? 4 : 16); return d; }
__device__ __forceinline__ void dattn_fetch(const DUnit& d, int tid, const bf16_t* QKV, const float* rel, u32x4 (&kv)[6], u32x4 (&vv)[6], bf16x8 (&qf)[4], float& bv) {
    const int lane = tid & 63, wid = tid >> 6, r = lane & 31, hh = lane >> 5;
    const int nk0 = 256 * d.qt - 128; const size_t hcol = (size_t)d.g * 256 + d.h * 64;
#pragma unroll
    for (int i = 0; i < 6; ++i) { const int e = tid + 512 * i, row = e >> 3, ch = e & 7; const int nk = nk0 + row;
        kv[i] = (u32x4){0u, 0u, 0u, 0u}; vv[i] = (u32x4){0u, 0u, 0u, 0u};
        if (nk >= 0) { const size_t tok = (size_t)d.b * SEQ + d.rs + (size_t)d.dil * nk; const bf16_t* src = QKV + tok * QKV_PITCH + hcol + ch * 8; kv[i] = *(const u32x4*)(src + 768); vv[i] = *(const u32x4*)(src + 1536); } }
    const int nq = 256 * d.qt + 32 * wid + r; const size_t qtok = (size_t)d.b * SEQ + d.rs + (size_t)d.dil * nq; const bf16_t* qrow = QKV + qtok * QKV_PITCH + hcol;
#pragma unroll
    for (int s = 0; s < 4; ++s) qf[s] = *(const bf16x8*)(qrow + 16 * s + 8 * hh);
    bv = (tid < 192) ? rel[(d.g * 4 + d.h) * 192 + tid] : 0.f;
}
__device__ __forceinline__ void dattn_units(LAS unsigned char* lds, bf16_t* QKV, float* LSE, const float* rel, int c, int G) {
    LAS char* Kl = (LAS char*)lds + LDS_K; LAS char* Vl = (LAS char*)lds + LDS_V; LAS float* biasL = (LAS float*)(lds + LDS_BIAS);
    int u = c; if (u >= 1536) return;
    DUnit d = dunit(u);
    u32x4 kv[6], vv[6]; bf16x8 qf[4]; float bv;
    dattn_fetch(d, tid_opaque(), QKV, rel, kv, vv, qf, bv);
    for (;;) {
        const int tid = tid_opaque(), lane = tid & 63, wid = __builtin_amdgcn_readfirstlane(tid >> 6), r = lane & 31, hh = lane >> 5;
#pragma unroll
        for (int i = 0; i < 6; ++i) { const int e = tid + 512 * i, row = e >> 3, ch = e & 7;
            *(LAS u32x4*)(Kl + row * 128 + ((ch ^ (row & 7)) << 4)) = kv[i]; *(LAS u32x4*)(Vl + row * 128 + (ch << 4)) = vv[i]; }
        if (tid < 192) biasL[tid] = bv;
        __syncthreads();
        const int un = u + G; const bool has_next = un < 1536; DUnit dn = d;
        u32x4 kvn[6], vvn[6]; bf16x8 qfn[4]; float bvn = 0.f;
        if (has_next) { dn = dunit(un); dattn_fetch(dn, tid, QKV, rel, kvn, vvn, qfn, bvn); }
        f32x16 o[2]; float m, l;
        dattn_wave(lane, Kl, Vl, 32 * wid, qf, biasL, (d.qt == 0) ? 4 - wid : 0, o, m, l);
        const int nq = 256 * d.qt + 32 * wid + r; const size_t qtok = (size_t)d.b * SEQ + d.rs + (size_t)d.dil * nq; bf16_t* qrow = QKV + qtok * QKV_PITCH + (size_t)d.g * 256 + d.h * 64;
        store_o<64>(hh, qrow, o, __builtin_amdgcn_rcpf(l));
        if (hh == 0) LSE[qtok * 12 + d.g * 4 + d.h] = m + __builtin_amdgcn_logf(l);
        __syncthreads();
        if (!has_next) break;
        u = un; d = dn; bv = bvn;
#pragma unroll
        for (int i = 0; i < 6; ++i) { kv[i] = kvn[i]; vv[i] = vvn[i]; }
#pragma unroll
        for (int s = 0; s < 4; ++s) qf[s] = qfn[s];
    }
}

__device__ __forceinline__ void xattn_units(LAS unsigned char* lds, bf16_t* XQ, const bf16_t* MEMKV, int b, int hd, int qt0, int nq) {
    const int tid = tid_opaque(), lane = tid & 63, wid = __builtin_amdgcn_readfirstlane(tid >> 6), r = lane & 31, hh = lane >> 5;
    LAS char* Kl = (LAS char*)lds + LDS_K; LAS char* Vl = (LAS char*)lds + LDS_V;
#pragma unroll
    for (int i = 0; i < 8; ++i) { const int e = tid + 512 * i, row = e >> 4, ch = e & 15; const bf16_t* src = MEMKV + (size_t)(b * MEM_LEN + row) * 1024 + hd * 128 + ch * 8;
        const u32x4 kv = *(const u32x4*)src, vv = *(const u32x4*)(src + 512);
        *(LAS u32x4*)(Kl + row * 256 + ((ch ^ (row & 7)) << 4)) = kv; *(LAS u32x4*)(Vl + row * 256 + (ch << 4)) = vv; }
    __syncthreads();
    for (int qi = 0; qi < nq; ++qi) {
        const int lane = tid_opaque() & 63, r = lane & 31, hh = lane >> 5;
        const size_t qtok = (size_t)b * SEQ + 256 * (qt0 + qi) + 32 * wid + r; bf16_t* qrow = XQ + qtok * 512 + hd * 128;
        bf16x8 qf[8];
#pragma unroll
        for (int s = 0; s < 8; ++s) qf[s] = *(const bf16x8*)(qrow + 16 * s + 8 * hh);
        f32x16 o[4]; float l;
        xattn_wave(lane, Kl, Vl, qf, o, l);
        store_o<128>(hh, qrow, o, __builtin_amdgcn_rcpf(l));
    }
    __syncthreads();
}

__device__ __forceinline__ void combine_rows(bf16_t* QKV, const float* LSE, int gw, int ngw) {
    const int lane = threadIdx.x & 63; const int h = lane >> 4, c = (lane & 15) * 4;
    for (int tok = gw; tok < MTOK; tok += ngw) {
        const float l0 = LSE[(size_t)tok * 12 + h], l1 = LSE[(size_t)tok * 12 + 4 + h], l2 = LSE[(size_t)tok * 12 + 8 + h];
        const float mx = fmaxf(l0, fmaxf(l1, l2)); float w0 = __builtin_amdgcn_exp2f(l0 - mx), w1 = __builtin_amdgcn_exp2f(l1 - mx), w2 = __builtin_amdgcn_exp2f(l2 - mx);
        const float inv = __builtin_amdgcn_rcpf(w0 + w1 + w2); w0 *= inv; w1 *= inv; w2 *= inv;
        bf16_t* p = QKV + (size_t)tok * QKV_PITCH + h * 64 + c;
        const u32x2 a = *(const u32x2*)p, bq = *(const u32x2*)(p + 256), cq = *(const u32x2*)(p + 512);
        u32x2 w; w.x = cvt_pk_bf16(w0 * bf_lo(a.x) + w1 * bf_lo(bq.x) + w2 * bf_lo(cq.x), w0 * bf_hi(a.x) + w1 * bf_hi(bq.x) + w2 * bf_hi(cq.x));
        w.y = cvt_pk_bf16(w0 * bf_lo(a.y) + w1 * bf_lo(bq.y) + w2 * bf_lo(cq.y), w0 * bf_hi(a.y) + w1 * bf_hi(bq.y) + w2 * bf_hi(cq.y));
        *(u32x2*)p = w;
    }
}
}
namespace ssm {
constexpr int L_WP = 0, L_BB = L_WP + 65 * 64 * 2 * 4, L_CC = L_BB + 64 * 16 * 2 * 4, L_KT = L_CC + 16 * 64 * 2 * 4;
static_assert(L_KT + 64 * 32 * 4 <= 131072, "ssm lds");

__device__ __forceinline__ void build_item(LAS unsigned char* lds, int item, const float* a_re, const float* a_im, const float* log_dt, const float* b_re, const float* b_im,
                                           const float* c_re, const float* c_im, const float* dsk, bf16_t* LP, bf16_t* QT) {
    const int tid = threadIdx.x, g = item >> 3, sub = item & 7;
    LAS float* WP = (LAS float*)(lds + L_WP); LAS float* BB = (LAS float*)(lds + L_BB); LAS float* CC = (LAS float*)(lds + L_CC); LAS float* KT = (LAS float*)(lds + L_KT);
    LAS float* CF = KT;
    if (tid < 64) { const int p = tid; const double dt = exp((double)log_dt[g]); const double ar = a_re[g * 64 + p], ai = a_im[g * 64 + p];
        const double mag = exp(ar * dt), ang = ai * dt, abr = mag * cos(ang), abi = mag * sin(ang), nr = abr - 1.0, ni = abi, den = ar * ar + ai * ai;
        CF[2 * p] = (float)((nr * ar + ni * ai) / den); CF[2 * p + 1] = (float)((ni * ar - nr * ai) / den);
        const float wr = (float)abr, wi = (float)abi; float xr = 1.f, xi = 0.f;
        for (int tau = 0; tau <= 64; ++tau) { WP[2 * (p * 65 + tau)] = xr; WP[2 * (p * 65 + tau) + 1] = xi; const float nxr = xr * wr - xi * wi, nxi = xr * wi + xi * wr; xr = nxr; xi = nxi; } }
    __syncthreads();
    for (int e = tid; e < 1024; e += 512) { const int p = e >> 4, h = e & 15; const float cr = CF[2 * p], ci = CF[2 * p + 1]; const float br = b_re[(g * 64 + p) * 16 + h], bi = b_im[(g * 64 + p) * 16 + h];
        BB[2 * e] = cr * br - ci * bi; BB[2 * e + 1] = cr * bi + ci * br;
        CC[2 * e] = c_re[(g * 16 + h) * 64 + p]; CC[2 * e + 1] = c_im[(g * 16 + h) * 64 + p]; }
    __syncthreads();
    { const int tau = tid >> 3, hs = (tid >> 2) & 1, hp0 = (tid & 3) * 4, h = 2 * sub + hs; float s0 = 0.f, s1 = 0.f, s2 = 0.f, s3 = 0.f;
        for (int p = 0; p < 64; ++p) { const f32x2 c = *(const LAS f32x2*)(CC + 2 * (p * 16 + h)), w = *(const LAS f32x2*)(WP + 2 * (p * 65 + tau));
            const float cwr = c.x * w.x - c.y * w.y, cwi = c.x * w.y + c.y * w.x; const LAS f32x2* bb = (const LAS f32x2*)(BB + 2 * (p * 16 + hp0));
            s0 += cwr * bb[0].x - cwi * bb[0].y; s1 += cwr * bb[1].x - cwi * bb[1].y; s2 += cwr * bb[2].x - cwi * bb[2].y; s3 += cwr * bb[3].x - cwi * bb[3].y; }
        if (tau == 0 && h >= hp0 && h < hp0 + 4) { const float dv = dsk[g * 16 + h]; if (h == hp0) s0 += dv; else if (h == hp0 + 1) s1 += dv; else if (h == hp0 + 2) s2 += dv; else s3 += dv; }
        *(LAS f32x4*)(KT + (tau * 2 + hs) * 16 + hp0) = (f32x4){s0, s1, s2, s3}; }
    __syncthreads();
    bf16_t* lp = LP + (size_t)g * 256 * LP_PITCH;
    for (int e = tid; e < 32 * 128; e += 512) { const int rr = e >> 7, c8 = e & 127, tl = rr >> 1, hs = rr & 1, n = tl * 16 + 2 * sub + hs, si = c8 >> 1, hp0 = (c8 & 1) * 8; const int tau = tl + 48 - si;
        u32x4 w = {0u, 0u, 0u, 0u};
        if (tau >= 0 && tau <= 63) { const LAS float* k = KT + (tau * 2 + hs) * 16 + hp0; w.x = cvt_pk_bf16(k[0], k[1]); w.y = cvt_pk_bf16(k[2], k[3]); w.z = cvt_pk_bf16(k[4], k[5]); w.w = cvt_pk_bf16(k[6], k[7]); }
        *(u32x4*)(lp + (size_t)n * LP_PITCH + c8 * 8) = w; }
    for (int e = tid; e < 32 * 64; e += 512) { const int rr = e >> 6, q = e & 63, j = q >> 4, p0 = (q & 15) * 4, tl = rr >> 1, hs = rr & 1, h = 2 * sub + hs, n = tl * 16 + h, tau = 16 * j + tl + 1; float v[8];
#pragma unroll
        for (int i = 0; i < 4; ++i) { const int p = p0 + i; const float cr = CC[2 * (p * 16 + h)], ci = CC[2 * (p * 16 + h) + 1], wr = WP[2 * (p * 65 + tau)], wi = WP[2 * (p * 65 + tau) + 1];
            v[2 * i] = cr * wr - ci * wi; v[2 * i + 1] = -(cr * wi + ci * wr); }
        u32x4 w; w.x = cvt_pk_bf16(v[0], v[1]); w.y = cvt_pk_bf16(v[2], v[3]); w.z = cvt_pk_bf16(v[4], v[5]); w.w = cvt_pk_bf16(v[6], v[7]);
        *(u32x4*)(lp + (size_t)n * LP_PITCH + 1024 + 128 * j + 2 * p0) = w; }
    bf16_t* qt = QT + (size_t)g * 128 * 1024;
    for (int e = tid; e < 16 * 128; e += 512) { const int rw = 16 * sub + (e >> 7), c8 = e & 127, p = rw >> 1, ri = rw & 1, s = c8 >> 1, hp0 = (c8 & 1) * 8; const int tau = 63 - s;
        const float wr = WP[2 * (p * 65 + tau)], wi = WP[2 * (p * 65 + tau) + 1]; float v[8];
#pragma unroll
        for (int i = 0; i < 8; ++i) { const float br = BB[2 * (p * 16 + hp0 + i)], bi = BB[2 * (p * 16 + hp0 + i) + 1]; v[i] = ri ? (wr * bi + wi * br) : (wr * br - wi * bi); }
        u32x4 w; w.x = cvt_pk_bf16(v[0], v[1]); w.y = cvt_pk_bf16(v[2], v[3]); w.z = cvt_pk_bf16(v[4], v[5]); w.w = cvt_pk_bf16(v[6], v[7]);
        *(u32x4*)(qt + (size_t)rw * 1024 + c8 * 8) = w; }
    __syncthreads();
}

__device__ __forceinline__ void carry_scan(int gthread, const float* a_re, const float* a_im, const float* log_dt, const float* SLOC, bf16_t* AG) {
    if (gthread >= 32 * 4 * 64) return;
    const int p = gthread & 63, b = (gthread >> 6) & 3, g = gthread >> 8;
    const double dt = exp((double)log_dt[g]); const double ar = a_re[g * 64 + p], ai = a_im[g * 64 + p]; const double mag = exp(ar * dt * 64.0), ang = ai * dt * 64.0;
    const float wr = (float)(mag * cos(ang)), wi = (float)(mag * sin(ang));
    float xr = 0.f, xi = 0.f;
    const f32x2* sl = (const f32x2*)(SLOC + ((size_t)g * 512 + b * 128) * 128) + p; unsigned* xo = (unsigned*)(AG + ((size_t)g * 512 + b * 128) * AG_PITCH + 1024) + p;
    for (int c0 = 0; c0 < 128; c0 += 64) {
        f32x2 s[64];
#pragma unroll
        for (int i = 0; i < 64; ++i) s[i] = sl[(size_t)(c0 + i) * 64];
#pragma unroll
        for (int i = 0; i < 64; ++i) { xo[(size_t)(c0 + i) * (AG_PITCH / 2)] = cvt_pk_bf16(xr, xi); const float nr = wr * xr - wi * xi + s[i].x, ni = wr * xi + wi * xr + s[i].y; xr = nr; xi = ni; }
    }
}
}

namespace prep {
__device__ __forceinline__ void transpose_item(const float* W, int K, int N, bf16_t* WT, int half, const float* gain, LAS float* scr, int item, int lane) {
    const int nblk = N / 32, kb = item / nblk, nb = item % nblk, k0 = 64 * kb, n0 = 32 * nb;
    float v[32];
#pragma unroll
    for (int i = 0; i < 32; ++i) { const int kk = 2 * i + (lane >> 5); v[i] = W[(size_t)(k0 + kk) * N + n0 + (lane & 31)]; }
    if (gain) {
#pragma unroll
        for (int i = 0; i < 32; ++i) v[i] *= gain[k0 + 2 * i + (lane >> 5)]; }
#pragma unroll
    for (int i = 0; i < 32; ++i) { const int kk = 2 * i + (lane >> 5); scr[kk * 33 + (lane & 31)] = v[i]; }
    asm volatile("s_waitcnt lgkmcnt(0)" ::: "memory");
    const int c = lane & 7;
#pragma unroll
    for (int j = 0; j < 4; ++j) { const int nl = (lane >> 3) + 8 * j; const LAS float* s = scr + (8 * c) * 33 + nl; int n = n0 + nl, row = n;
        if (half > 0) { const int isb = n >= half; const int cc = isb ? n - half : n; row = (cc >> 7) * 256 + (isb ? 128 : 0) + (cc & 127); }
        u32x4 o; o.x = cvt_pk_bf16(s[0 * 33], s[1 * 33]); o.y = cvt_pk_bf16(s[2 * 33], s[3 * 33]); o.z = cvt_pk_bf16(s[4 * 33], s[5 * 33]); o.w = cvt_pk_bf16(s[6 * 33], s[7 * 33]);
        *(u32x4*)(WT + (size_t)row * K + k0 + 8 * c) = o; }
    asm volatile("s_waitcnt lgkmcnt(0)" ::: "memory");
}
template <int NR> __device__ __forceinline__ void rows_to_bf16(const float* xrow, bf16_t* orow, float* ss, int lane) {
    f32x4 v[NR][4];
#pragma unroll
    for (int q = 0; q < NR; ++q)
#pragma unroll
        for (int j = 0; j < 4; ++j) v[q][j] = ((const f32x4*)(xrow + (size_t)q * D_MODEL) + lane)[64 * j];
#pragma unroll
    for (int q = 0; q < NR; ++q) { float s = 0.f;
#pragma unroll
        for (int j = 0; j < 4; ++j) s += (v[q][j][0] * v[q][j][0] + v[q][j][1] * v[q][j][1]) + (v[q][j][2] * v[q][j][2] + v[q][j][3] * v[q][j][3]);
        s = wave_sum(s);
        u32x2* o8 = (u32x2*)(orow + (size_t)q * D_MODEL) + lane;
#pragma unroll
        for (int j = 0; j < 4; ++j) { u32x2 w; w.x = cvt_pk_bf16(v[q][j][0], v[q][j][1]); w.y = cvt_pk_bf16(v[q][j][2], v[q][j][3]); o8[64 * j] = w; }
        if (lane == 0) ss[q] = s; }
}
template <int NR> __device__ __forceinline__ void final_rows(float* xrow, const float* ss4, int row, const float* gain, int lane) {
    f32x4 v[NR][4]; float r[NR];
#pragma unroll
    for (int q = 0; q < NR; ++q) {
#pragma unroll
        for (int j = 0; j < 4; ++j) v[q][j] = ((const f32x4*)(xrow + (size_t)q * D_MODEL) + lane)[64 * j];
        r[q] = rsqrtf(((ss4[row + q] + ss4[MTOK + row + q]) + (ss4[2 * MTOK + row + q] + ss4[3 * MTOK + row + q])) * (1.f / D_MODEL) + EPS); }
    f32x4 g[4];
#pragma unroll
    for (int j = 0; j < 4; ++j) g[j] = ((const f32x4*)gain + lane)[64 * j];
#pragma unroll
    for (int q = 0; q < NR; ++q)
#pragma unroll
        for (int j = 0; j < 4; ++j) ((f32x4*)(xrow + (size_t)q * D_MODEL) + lane)[64 * j] = v[q][j] * r[q] * g[j];
}
}
#define RLX_AGENT __ATOMIC_RELAXED, __HIP_MEMORY_SCOPE_AGENT
#define XB_TMO      128
#define XB_XCNT(j)  (256  + 64 * (j))
#define XB_XSUB(j)  (1280 + 64 * (j))
#define XB_XGEN(j)  (2304 + 64 * (j))
#define XB_TOP      3328
#define XB_TOPGEN   3392
#define XCD_BAR_WORDS 3456
#define XB_SPIN_CAP (1u << 22)
__device__ __forceinline__ unsigned xb_ld(unsigned* p)              { return __hip_atomic_load(p, __ATOMIC_RELAXED, __HIP_MEMORY_SCOPE_AGENT); }
__device__ __forceinline__ unsigned xb_add(unsigned* p, unsigned v) { return __hip_atomic_fetch_add(p, v, __ATOMIC_RELAXED, __HIP_MEMORY_SCOPE_AGENT); }
__device__ __forceinline__ unsigned xb_xcc_id() { return (unsigned)__builtin_amdgcn_s_getreg((3 << 11) | 20) & 0xFu; }
#define XB_SPIN(cond, bar) do { unsigned _sp = 0; while (cond) { __builtin_amdgcn_s_sleep(1); \
    if ((++_sp & 255u) == 0u) { if (xb_ld(&(bar)[XB_TMO])) break; if (_sp > XB_SPIN_CAP) { atomicAdd(&(bar)[XB_TMO], 1u); break; } } } } while (0)
struct XcdBarrier { unsigned* bar; unsigned x; volatile LAS unsigned* st; };
__device__ __forceinline__ XcdBarrier xcd_barrier_post(unsigned* bar, volatile LAS unsigned* st) {
    XcdBarrier b; b.bar = bar; b.x = xb_xcc_id(); b.st = st;
    if (threadIdx.x == 0) (void)xb_add(&bar[XB_XCNT(b.x)], 1u);
    return b;
}
__device__ __forceinline__ void xcd_barrier_complete(unsigned* bar, unsigned x, unsigned& nloc, unsigned& nx) {
    const unsigned G = gridDim.x * gridDim.y * gridDim.z;
    unsigned sum, cnt, mine, sp = 0u;
    for (;;) {
        sum = 0u; cnt = 0u; mine = 0u;
#pragma unroll
        for (unsigned j = 0; j < 16; ++j) { const unsigned c = xb_ld(&bar[XB_XCNT(j)]); sum += c; cnt += (c > 0u) ? 1u : 0u; mine = (j == x) ? c : mine; }
        if (sum == G) break;
        __builtin_amdgcn_s_sleep(1);
        if ((++sp & 255u) == 0u) { if (xb_ld(&bar[XB_TMO])) break; if (sp > XB_SPIN_CAP) { atomicAdd(&bar[XB_TMO], 1u); break; } }
    }
    nloc = mine > 0u ? mine : 1u; nx = cnt > 0u ? cnt : 1u;
}
__device__ __forceinline__ void xcd_barrier(const XcdBarrier& b) {
    asm volatile("s_waitcnt vmcnt(0)" ::: "memory");
    __syncthreads();
    if (threadIdx.x == 0) {
        unsigned* bar = b.bar;
        __builtin_amdgcn_s_waitcnt(0);
        unsigned nloc = b.st[0], nx = b.st[1];
        if (nloc == 0u) { xcd_barrier_complete(bar, b.x, nloc, nx); b.st[0] = nloc; b.st[1] = nx; }
        const unsigned old = xb_add(&bar[XB_XSUB(b.x)], 1u);
        const unsigned gen = old / nloc;
        if (old + 1u == (gen + 1u) * nloc) {
            __builtin_amdgcn_fence(__ATOMIC_RELEASE, "agent");
            asm volatile("s_waitcnt vmcnt(0)" ::: "memory");
            const unsigned og = xb_add(&bar[XB_TOP], 1u);
            const unsigned tg = og / nx;
            if (og + 1u == (tg + 1u) * nx) xb_add(&bar[XB_TOPGEN], 1u);
            else XB_SPIN(xb_ld(&bar[XB_TOPGEN]) == tg, bar);
            __builtin_amdgcn_fence(__ATOMIC_ACQUIRE, "agent");
            xb_add(&bar[XB_XGEN(b.x)], 1u);
            asm volatile("s_waitcnt vmcnt(0)" ::: "memory");
        } else {
            XB_SPIN(xb_ld(&bar[XB_XGEN(b.x)]) == gen, bar);
            __builtin_amdgcn_fence(__ATOMIC_ACQUIRE, "agent");
            asm volatile("s_waitcnt vmcnt(0)" ::: "memory");
        }
    }
    __syncthreads();
}

constexpr int LDS_STAGE = 0;
constexpr int LDS_EPI = 131072;
constexpr int LDS_BIASTAB = 131072 + 4096;
constexpr int LDS_MISC = 131072 + 4096 + 1024;
constexpr int LDS_BYTES = 147456;
constexpr int NPHASE = 15;

struct Args { const float* in[26]; float* out; unsigned char* ws; int ph_lo, ph_hi; };
__device__ __forceinline__ int tid_now() { int t = threadIdx.x; asm volatile("" : "+v"(t)); return t; }
#ifndef STG3
#define STG3 0
#endif
#ifndef STG2
#define STG2 0
#endif
__device__ __forceinline__ void stagger(int c, unsigned ticks) { const unsigned grp = ((unsigned)c >> 3) & 3u; if (ticks && grp) { const unsigned long long t0 = __builtin_amdgcn_s_memrealtime(); while (__builtin_amdgcn_s_memrealtime() - t0 < (unsigned long long)(grp * ticks)) __builtin_amdgcn_s_sleep(4); } }
#define PHASE_IDS const int tid = tid_now(), lane = tid & 63, wave = __builtin_amdgcn_readfirstlane(tid >> 6), gw = c * 8 + wave, NGW = G * 8; LAS float* scr = (LAS float*)(lds + LDS_STAGE + wave * 16384); (void)lane; (void)gw; (void)NGW; (void)scr;

__global__ void __launch_bounds__(512, 2) mega_fwd(Args args) {
    extern __shared__ __attribute__((aligned(16))) unsigned char lds_raw[];
    LAS unsigned char* lds = (LAS unsigned char*)lds_raw;
    const int G = gridDim.x, c = blockIdx.x;
    unsigned char* ws = args.ws;
    const float* const* in = args.in;
    volatile LAS unsigned* MISC = (volatile LAS unsigned*)(lds + LDS_MISC);
    if (threadIdx.x < 64) MISC[threadIdx.x] = 0u;
    __syncthreads();
    const int lo = args.ph_lo, hi = args.ph_hi;
    const bool multi = (hi - lo) > 1;
    XcdBarrier bar; bar.bar = (unsigned*)(ws + WS_CTL); bar.x = 0; bar.st = nullptr;
    if (multi) bar = xcd_barrier_post((unsigned*)(ws + WS_CTL), MISC);
#define IN(k) (lo <= (k) && (k) < hi)
#ifdef PROBE_EPI
#define EPIFLAG(k) do { if (threadIdx.x == 0) MISC[17] = ((k) >= PROBE_LO && (k) <= PROBE_HI) ? 1u : 0u; __syncthreads(); } while (0)
#else
#define EPIFLAG(k) do { } while (0)
#endif
#ifdef PROBE_LO
    unsigned long long tstamp[NPHASE + 1]; const bool stamper = (c == 0 && threadIdx.x == 0);
    tstamp[0] = __builtin_amdgcn_s_memrealtime();
#if defined(PROBE_SUB)
#define SEAM(k) do { if (IN(k) && IN((k) + 1)) xcd_barrier(bar); } while (0)
#else
#define SEAM(k) do { if (IN(k) && IN((k) + 1)) xcd_barrier(bar); if ((k) + 1 == PROBE_LO) tstamp[0] = __builtin_amdgcn_s_memrealtime(); if ((k) == PROBE_HI) tstamp[1] = __builtin_amdgcn_s_memrealtime(); } while (0)
#endif
#else
#define SEAM(k) do { if (IN(k) && IN((k) + 1)) xcd_barrier(bar); } while (0)
#endif

    float* OUT = args.out;
    float* SS1 = (float*)(ws + WS_SS1); float* SS2 = (float*)(ws + WS_SS2); float* SS3 = (float*)(ws + WS_SS3); float* SS4 = (float*)(ws + WS_SS4); float* SSMEM = (float*)(ws + WS_SSM);
    bf16_t* MEMB = (bf16_t*)(ws + WS_MEMB); bf16_t* MEMKV = (bf16_t*)(ws + WS_MEMKV);
    bf16_t* WIN = (bf16_t*)(ws + WS_WIN); bf16_t* WGLU = (bf16_t*)(ws + WS_WGLU); bf16_t* WAU = (bf16_t*)(ws + WS_WAU); bf16_t* WKV = (bf16_t*)(ws + WS_WKV);
    bf16_t* WMU = (bf16_t*)(ws + WS_WMU); bf16_t* WOUT = (bf16_t*)(ws + WS_WOUT); bf16_t* WFIN = (bf16_t*)(ws + WS_WFIN); bf16_t* WFDN = (bf16_t*)(ws + WS_WFDN);
    bf16_t* XB = (bf16_t*)(ws + WS_XB); bf16_t* LP = (bf16_t*)(ws + WS_LP); bf16_t* QT = (bf16_t*)(ws + WS_QT); float* SLOC = (float*)(ws + WS_SLOC); float* LSE = (float*)(ws + WS_LSE);
    bf16_t* HB = (bf16_t*)(ws + WS_H); bf16_t* QKV = (bf16_t*)(ws + WS_QKV); bf16_t* XQ = (bf16_t*)(ws + WS_XQ); bf16_t* AG = (bf16_t*)(ws + WS_AG); bf16_t* GATE = (bf16_t*)(ws + WS_GATE);
    bf16_t* GATE_S = GATE; bf16_t* MERGED = GATE + (size_t)MTOK * D_MODEL; bf16_t* GATE_M = GATE + 2 * (size_t)MTOK * D_MODEL;

    if (IN(0)) { PHASE_IDS
        constexpr int I_FIN = 16 * 176, I_FDN = 44 * 32, I_WIN = 16 * 200, I_GLU = 8 * 64, I_AU = 4 * 32, I_KV = 16 * 32, I_MU = 8 * 32, I_OUT = 16 * 32;
        constexpr int NIT = I_FIN + I_FDN + I_WIN + I_GLU + I_AU + I_KV + I_MU + I_OUT;
        for (int it = gw; it < NIT; it += NGW) { int r = it;
            if (r < I_FIN) { prep::transpose_item(in[3], 1024, 5632, WFIN, 2816, in[2], scr, r, lane); continue; } r -= I_FIN;
            if (r < I_FDN) { prep::transpose_item(in[4], 2816, 1024, WFDN, 0, nullptr, scr, r, lane); continue; } r -= I_FDN;
            if (r < I_WIN) { prep::transpose_item(in[6], 1024, 6400, WIN, 0, in[5], scr, r, lane); continue; } r -= I_WIN;
            if (r < I_GLU) { prep::transpose_item(in[15], 512, 2048, WGLU, 1024, nullptr, scr, r, lane); continue; } r -= I_GLU;
            if (r < I_AU) { prep::transpose_item(in[17], 256, 1024, WAU, 0, nullptr, scr, r, lane); continue; } r -= I_AU;
            if (r < I_KV) { prep::transpose_item(in[19], 1024, 1024, WKV, 0, in[18], scr, r, lane); continue; } r -= I_KV;
            if (r < I_MU) { prep::transpose_item(in[20], 512, 1024, WMU, 0, nullptr, scr, r, lane); continue; } r -= I_MU;
            prep::transpose_item(in[21], 1024, 1024, WOUT, 0, nullptr, scr, r, lane);
        }
        for (int m = gw * 4; m < MTOK; m += NGW * 4) prep::rows_to_bf16<4>(in[0] + (size_t)m * D_MODEL, XB + (size_t)m * D_MODEL, SS1 + m, lane);
        att::build_bias(in[16], (float*)(ws + WS_BIAS), c * 512 + tid);
        for (int m = gw; m < MEMROWS; m += NGW) prep::rows_to_bf16<1>(in[1] + (size_t)m * D_MODEL, MEMB + (size_t)m * D_MODEL, SSMEM + m, lane);
    }
    SEAM(0);
    if (IN(1)) { EPIFLAG(1);
        g8::OrdDense S{(const char*)XB, (const char*)WFIN, 128, 22, 16, G, c, (size_t)256 * 1024 * 2, (size_t)256 * 1024 * 2};
        g8::EpiSwiglu E{HB, SS1, 1};
        g8::gemm_phase<g8::EpiSwiglu, g8::OrdDense, false>(lds, g8::Cfg{1024, 1024, (size_t)128 * 1024 * 2, (size_t)128 * 1024 * 2}, S, E);
    }
    SEAM(1);
    if (IN(2)) { EPIFLAG(2); stagger(c, STG2);
        g8::OrdDense S{(const char*)HB, (const char*)WFDN, 128, 4, 44, G, c, (size_t)256 * D_FF * 2, (size_t)256 * D_FF * 2};
        g8::EpiResid E{in[0], OUT, XB, SS2, 0.5f};
        g8::gemm_phase<g8::EpiResid, g8::OrdDense, false>(lds, g8::Cfg{D_FF, D_FF, (size_t)128 * D_FF * 2, (size_t)128 * D_FF * 2}, S, E);
    }
    SEAM(2);
    if (IN(3)) { EPIFLAG(3); stagger(c, STG3);
        g8::OrdProj S{(const char*)XB, (const char*)WIN, (const char*)MEMB, (const char*)WKV, G, c};
        g8::EpiProj E{SS2, SSMEM, AG, QKV, XQ, GATE, MEMKV};
        g8::gemm_phase<g8::EpiProj, g8::OrdProj, false>(lds, g8::Cfg{1024, 1024, (size_t)128 * 1024 * 2, (size_t)128 * 1024 * 2}, S, E);
        { const int rounds = (3216 + G - 1) / G, first_light = 3216 - (rounds - 1) * G, nlight = G - first_light;
          if (c >= first_light && nlight > 0) { PHASE_IDS const int lw = (c - first_light) * 8 + wave, nlw = nlight * 8;
            constexpr int I_FIN = 16 * 176, I_FDN = 44 * 32;
            for (int it = lw; it < I_FIN + I_FDN; it += nlw) {
                if (it < I_FIN) prep::transpose_item(in[23], 1024, 5632, WFIN, 2816, in[22], scr, it, lane);
                else prep::transpose_item(in[24], 2816, 1024, WFDN, 0, nullptr, scr, it - I_FIN, lane); } } }
    }
    SEAM(3);
    if (IN(4)) {
#if defined(PROBE_SUB)
#define SUBT(k) do { if (PROBE_SUB == (k)) tstamp[0] = __builtin_amdgcn_s_memrealtime(); if (PROBE_SUB + 1 == (k)) tstamp[1] = __builtin_amdgcn_s_memrealtime(); } while (0)
#else
#define SUBT(k) do { } while (0)
#endif
        SUBT(1);
        for (int it = c; it < 256; it += G) ssm::build_item(lds, it, in[7], in[8], in[9], in[10], in[11], in[12], in[13], in[14], LP, QT);
        SUBT(2);
        att::dattn_units(lds, QKV, LSE, (const float*)(ws + WS_BIAS), c, G);
        SUBT(3);
        for (int pi = c; pi < 256; pi += G) att::xattn_units(lds, XQ, MEMKV, pi >> 6, (pi >> 4) & 3, 2 * (pi & 15), 2);
        SUBT(4);
    }
    SEAM(4);
    if (IN(5)) { EPIFLAG(5); PHASE_IDS
        { g8::OrdSloc S{(const char*)AG, (const char*)QT, G, c}; g8::EpiSloc E{SLOC};
          g8::gemm_phase<g8::EpiSloc, g8::OrdSloc, false>(lds, g8::Cfg{AG_PITCH, 1024, (size_t)128 * AG_PITCH * 2, 0}, S, E); }
        { const int ns = (G > 128) ? 64 : 0;
          if (c >= ns) att::combine_rows(QKV, LSE, (c - ns) * 8 + wave, (G - ns) * 8); }
    }
    SEAM(5);
    if (IN(6)) { if (c < 16) ssm::carry_scan(c * 512 + tid_now(), in[7], in[8], in[9], SLOC, AG); }
    SEAM(6);
    if (IN(7)) { EPIFLAG(7);
        g8::OrdY S{(const char*)AG, (const char*)LP, G, c}; g8::EpiY E{QKV + 768};
        g8::gemm_phase<g8::EpiY, g8::OrdY, true>(lds, g8::Cfg{AG_PITCH, LP_PITCH, (size_t)128 * AG_PITCH * 2, (size_t)128 * LP_PITCH * 2}, S, E);
    }
    SEAM(7);
    if (IN(8)) { EPIFLAG(8);
        g8::OrdDense S{(const char*)QKV, (const char*)WAU, 128, 4, 4, G, c, (size_t)256 * QKV_PITCH * 2, (size_t)256 * 256 * 2}; g8::EpiMerge<0> E{MERGED, MERGED};
        g8::gemm_phase<g8::EpiMerge<0>, g8::OrdDense, false>(lds, g8::Cfg{QKV_PITCH, 256, (size_t)128 * QKV_PITCH * 2, (size_t)128 * 256 * 2}, S, E);
    }
    SEAM(8);
    if (IN(9)) { EPIFLAG(9);
        g8::OrdDense S{(const char*)XQ, (const char*)WMU, 128, 4, 8, G, c, (size_t)256 * 512 * 2, (size_t)256 * 512 * 2}; g8::EpiMerge<1> E{GATE_M, MERGED};
        g8::gemm_phase<g8::EpiMerge<1>, g8::OrdDense, false>(lds, g8::Cfg{512, 512, (size_t)128 * 512 * 2, (size_t)128 * 512 * 2}, S, E);
    }
    SEAM(9);
    if (IN(10)) { EPIFLAG(10);
        g8::OrdDense S{(const char*)(QKV + 768), (const char*)WGLU, 128, 8, 8, G, c, (size_t)256 * QKV_PITCH * 2, (size_t)256 * 512 * 2}; g8::EpiMerge<2> E{GATE_S, MERGED};
        g8::gemm_phase<g8::EpiMerge<2>, g8::OrdDense, false>(lds, g8::Cfg{QKV_PITCH, 512, (size_t)128 * QKV_PITCH * 2, (size_t)128 * 512 * 2}, S, E);
    }
    SEAM(10);
    if (IN(11)) { EPIFLAG(11);
        g8::OrdDense S{(const char*)MERGED, (const char*)WOUT, 128, 4, 16, G, c, (size_t)256 * 1024 * 2, (size_t)256 * 1024 * 2}; g8::EpiResid E{OUT, OUT, XB, SS3, 1.0f};
        g8::gemm_phase<g8::EpiResid, g8::OrdDense, false>(lds, g8::Cfg{1024, 1024, (size_t)128 * 1024 * 2, (size_t)128 * 1024 * 2}, S, E);
    }
    SEAM(11);
    if (IN(12)) { EPIFLAG(12);
        g8::OrdDense S{(const char*)XB, (const char*)WFIN, 128, 22, 16, G, c, (size_t)256 * 1024 * 2, (size_t)256 * 1024 * 2}; g8::EpiSwiglu E{HB, SS3, 4};
        g8::gemm_phase<g8::EpiSwiglu, g8::OrdDense, false>(lds, g8::Cfg{1024, 1024, (size_t)128 * 1024 * 2, (size_t)128 * 1024 * 2}, S, E);
    }
    SEAM(12);
    if (IN(13)) { EPIFLAG(13);
        g8::OrdDense S{(const char*)HB, (const char*)WFDN, 128, 4, 44, G, c, (size_t)256 * D_FF * 2, (size_t)256 * D_FF * 2}; g8::EpiResid E{OUT, OUT, XB, SS4, 0.5f};
        g8::gemm_phase<g8::EpiResid, g8::OrdDense, false>(lds, g8::Cfg{D_FF, D_FF, (size_t)128 * D_FF * 2, (size_t)128 * D_FF * 2}, S, E);
    }
    SEAM(13);
    if (IN(14)) { PHASE_IDS for (int m = gw * 4; m < MTOK; m += NGW * 4) prep::final_rows<4>(OUT + (size_t)m * D_MODEL, SS4, m, in[25], lane); }
#ifdef PROBE_LO
    if (PROBE_HI == 14) { __syncthreads(); tstamp[1] = __builtin_amdgcn_s_memrealtime(); }
#ifdef PROBE_EPI
    if (stamper) { tstamp[0] = 0; tstamp[1] = MISC[16]; }
#endif
    if (stamper) { const unsigned long long want = (tstamp[1] - tstamp[0]) * PROBE_MULT, t1 = __builtin_amdgcn_s_memrealtime(); while (__builtin_amdgcn_s_memrealtime() - t1 < want) __builtin_amdgcn_s_sleep(8); }
#endif
#undef IN
#undef SEAM
}

#ifndef MK_MULTI
#define MK_MULTI 1
#endif
extern "C" void kernel_launch(void* const* d_in, const int* in_sizes, int n_in, void* d_out, int out_size, void* d_ws, size_t ws_size, hipStream_t stream) {
    static int grid = 0;
    if (!grid) {
        if (n_in != 26 || in_sizes[0] != MTOK * D_MODEL || out_size != MTOK * D_MODEL || ws_size < WS_END) { fprintf(stderr, "kernel_launch: unexpected problem: n_in %d, in0 %d, out %d, ws %zu (need %zu)\n", n_in, n_in > 0 ? in_sizes[0] : -1, out_size, ws_size, (size_t)WS_END); grid = -1; return; }
        if (hipFuncSetAttribute((const void*)mega_fwd, hipFuncAttributeMaxDynamicSharedMemorySize, LDS_BYTES) != hipSuccess) { fprintf(stderr, "kernel_launch: hipFuncSetAttribute failed\n"); grid = -1; return; }
        int dev = 0, cus = 0, per_cu = 0;
        if (hipGetDevice(&dev) != hipSuccess || hipDeviceGetAttribute(&cus, hipDeviceAttributeMultiprocessorCount, dev) != hipSuccess) { fprintf(stderr, "kernel_launch: device query failed\n"); grid = -1; return; }
        if (hipOccupancyMaxActiveBlocksPerMultiprocessor(&per_cu, (const void*)mega_fwd, 512, LDS_BYTES) != hipSuccess || per_cu < 1) { fprintf(stderr, "kernel_launch: occupancy query says %d blocks per CU\n", per_cu); grid = -1; return; }
        grid = cus;
        if (grid > 256) grid = 256;
        if (grid < 32) { fprintf(stderr, "kernel_launch: %d CUs is too few\n", cus); grid = -1; return; }
    }
    if (grid < 0) return;
    (void)hipMemsetAsync((char*)d_ws + WS_CTL, 0, 64 * 1024, stream);
    Args a{};
    for (int i = 0; i < 26; ++i) a.in[i] = (const float*)d_in[i];
    a.out = (float*)d_out; a.ws = (unsigned char*)d_ws;
#if MK_MULTI
    for (int p = 0; p < NPHASE; ++p) { a.ph_lo = p; a.ph_hi = p + 1; hipLaunchKernelGGL(mega_fwd, dim3(grid), dim3(512), LDS_BYTES, stream, a); }
#else
    a.ph_lo = 0; a.ph_hi = NPHASE;
    void* kargs[] = {&a};
    hipError_t e = hipLaunchCooperativeKernel((const void*)mega_fwd, dim3(grid), dim3(512), kargs, LDS_BYTES, stream);
    if (e != hipSuccess) fprintf(stderr, "kernel_launch: cooperative launch failed: %s (grid %d)\n", hipGetErrorString(e), grid);
#endif
}
```
